# Optimizing an MI355X kernel written in HIP

```python
import jax, jax.numpy as jnp
from jax import lax
import numpy as np

D_MODEL = 2048
BATCH = 4
SEQ = 2048
DEPTH = 2
DEC_BATCH = 128
DEC_SEQ = 8
PAST_LEN = 16384
PAGE_SIZE = 128

N_META = 16
CONV_WIDTH = 3
CONV_HIST = CONV_WIDTH - 1
POOL_WINDOWS = (2, 4, 8, 16)
N_POOL_GROUPS = len(POOL_WINDOWS)
POOL_GROUP_DIM = D_MODEL // N_POOL_GROUPS
POOL_HIST = max(POOL_WINDOWS) - 1
D_FF = ((8 * D_MODEL + 3 * 256 - 1) // (3 * 256)) * 256
N_CONV_LAYERS = (DEPTH + 1) // 2
N_POOL_LAYERS = DEPTH // 2
EPS = 1e-6

kernel_name = "hybrid_shortconv_pool_decoder_step"


def rmsnorm(x, g):
    xf = x.astype(jnp.float32)
    y = xf * lax.rsqrt(jnp.mean(xf * xf, axis=-1, keepdims=True) + EPS)
    return (y * g.astype(jnp.float32)).astype(x.dtype)


def conv_mixer(h, hist, w_in, w_dw, w_out):
    T = h.shape[1]
    bcv = h @ w_in
    b, c, v = jnp.split(bcv, 3, axis=-1)
    u = c * v
    u_full = jnp.concatenate([hist.astype(u.dtype), u], axis=1)
    conv = sum(w_dw[k] * u_full[:, k:k + T] for k in range(CONV_WIDTH))
    y = (b * conv) @ w_out
    return y, u_full[:, -CONV_HIST:]


def pool_mixer(h, hist, t0, w_pool, scale):
    B, T, D = h.shape
    u = jnp.concatenate([hist.astype(h.dtype), h], axis=1)
    cs = jnp.cumsum(u.astype(jnp.float32), axis=1)
    cs = jnp.concatenate([jnp.zeros((B, 1, D), jnp.float32), cs], axis=1)
    end = cs[:, POOL_HIST + 1:POOL_HIST + 1 + T]
    start = jnp.concatenate(
        [cs[:, POOL_HIST + 1 - w:POOL_HIST + 1 - w + T, g * POOL_GROUP_DIM:(g + 1) * POOL_GROUP_DIM]
         for g, w in enumerate(POOL_WINDOWS)], axis=-1)
    win = jnp.repeat(jnp.asarray(POOL_WINDOWS, jnp.float32), POOL_GROUP_DIM)
    pos = (t0 + jnp.arange(T, dtype=jnp.int32)).astype(jnp.float32)
    count = jnp.minimum(win[None, :], pos[:, None] + 1.0)
    p = ((end - start) / count - h.astype(jnp.float32)).astype(h.dtype)
    pg = p.reshape(B, T, N_POOL_GROUPS, POOL_GROUP_DIM)
    out = jnp.einsum('btgc,gcd->btgd', pg, w_pool).reshape(B, T, D)
    return out * scale, u[:, -POOL_HIST:]


def swiglu(h, w_gu, w_down):
    g, u = jnp.split(h @ w_gu, 2, axis=-1)
    return (jax.nn.silu(g) * u) @ w_down


def trunk(x, conv_states, pool_states, t0, norm_mix, norm_ffn, norm_final,
          conv_w_in, conv_w_dw, conv_w_out, pool_w, pool_scale, ffn_w_gate_up, ffn_w_down):
    h = x
    new_conv, new_pool = [], []
    for i in range(DEPTH):
        n = rmsnorm(h, norm_mix[i])
        j = i // 2
        if i % 2 == 0:
            y, s = conv_mixer(n, conv_states[j], conv_w_in[j], conv_w_dw[j], conv_w_out[j])
            new_conv.append(s)
        else:
            y, s = pool_mixer(n, pool_states[j], t0, pool_w[j], pool_scale[j])
            new_pool.append(s)
        h = h + y
        h = h + swiglu(rmsnorm(h, norm_ffn[i]), ffn_w_gate_up[i], ffn_w_down[i])
    return rmsnorm(h, norm_final), jnp.stack(new_conv), jnp.stack(new_pool)


def setup_inputs(seed: int = 0) -> dict:
    key = jax.random.key(seed)
    ks = jax.random.split(key, 16)
    f32 = jnp.float32
    D, F = D_MODEL, D_FF
    nrm = lambda k, s, sc: jax.random.normal(k, s, f32) * sc
    return {
        "x_prompt": nrm(ks[0], (BATCH, SEQ, D), 1.0),
        "x_sample": nrm(ks[1], (DEC_BATCH, DEC_SEQ, D), 1.0),
        "state_conv": nrm(ks[2], (N_CONV_LAYERS, DEC_BATCH, CONV_HIST, D), 1.0),
        "state_pool": nrm(ks[3], (N_POOL_LAYERS, DEC_BATCH, POOL_HIST, D), 1.0),
        "meta_tokens": nrm(ks[4], (N_META, D), 1.0),
        "norm_mix": 1.0 + nrm(ks[5], (DEPTH, D), 0.05),
        "norm_ffn": 1.0 + nrm(ks[6], (DEPTH, D), 0.05),
        "norm_final": 1.0 + nrm(ks[7], (D,), 0.05),
        "conv_w_in": nrm(ks[8], (N_CONV_LAYERS, D, 3 * D), D ** -0.5),
        "conv_w_dw": nrm(ks[9], (N_CONV_LAYERS, CONV_WIDTH, D), CONV_WIDTH ** -0.5),
        "conv_w_out": nrm(ks[10], (N_CONV_LAYERS, D, D), D ** -0.5),
        "pool_w": nrm(ks[11], (N_POOL_LAYERS, N_POOL_GROUPS, POOL_GROUP_DIM, POOL_GROUP_DIM), POOL_GROUP_DIM ** -0.5),
        "pool_scale": 1.0 + nrm(ks[12], (N_POOL_LAYERS, D), 0.1),
        "ffn_w_gate_up": nrm(ks[13], (DEPTH, D, 2 * F), D ** -0.5),
        "ffn_w_down": nrm(ks[14], (DEPTH, F, D), F ** -0.5),
    }


def reference(x_prompt, x_sample, state_conv, state_pool, meta_tokens, norm_mix, norm_ffn, norm_final,
              conv_w_in, conv_w_dw, conv_w_out, pool_w, pool_scale, ffn_w_gate_up, ffn_w_down):
    weights = (norm_mix, norm_ffn, norm_final, conv_w_in, conv_w_dw, conv_w_out,
               pool_w, pool_scale, ffn_w_gate_up, ffn_w_down)
    B = x_prompt.shape[0]
    meta = jnp.broadcast_to(meta_tokens.astype(x_prompt.dtype)[None], (B, N_META, D_MODEL))
    xp = jnp.concatenate([meta, x_prompt], axis=1)
    zc = jnp.zeros((N_CONV_LAYERS, B, CONV_HIST, D_MODEL), x_prompt.dtype)
    zp = jnp.zeros((N_POOL_LAYERS, B, POOL_HIST, D_MODEL), x_prompt.dtype)
    yp, new_conv_prompt, new_pool_prompt = trunk(xp, zc, zp, 0, *weights)
    y_prompt = yp[:, N_META:]
    y_sample, new_conv_sample, new_pool_sample = trunk(x_sample, state_conv, state_pool, PAST_LEN, *weights)
    return (y_prompt, y_sample, new_conv_prompt, new_pool_prompt, new_conv_sample, new_pool_sample)
```

```cpp
#include <hip/hip_runtime.h>
#include <hip/hip_cooperative_groups.h>
#include <cstdio>
#include <cstdint>
namespace cg = cooperative_groups;

namespace pg8 {
#define PG8_LAS __attribute__((address_space(3)))
typedef unsigned short bf16_t;
typedef short bf16x8 __attribute__((ext_vector_type(8)));
typedef float f32x4 __attribute__((ext_vector_type(4)));
typedef unsigned u32x4 __attribute__((ext_vector_type(4)));
constexpr int BM = 256, BK = 64, HALF = 128, HTB = HALF * BK * 2  , STAGE_BYTES = 8 * HTB, NXCD = 8, WGM = 8;

__host__ __device__ __forceinline__ int lds_byte(int r, int c) { const int st = (r >> 4) * 2 + (c >> 5), rr = r & 15, cc = c & 31, ob = rr * 64 + cc * 2; return st * 1024 + (ob ^ (((ob >> 9) & 1) << 5)); }
__host__ __device__ __forceinline__ void stage_rc(int b, int& R, int& C) { const int st = b / 1024, sb = b % 1024, swz = sb ^ (((sb >> 9) & 1) << 5); R = (st >> 1) * 16 + swz / 64; C = (st & 1) * 32 + (swz % 64) / 2; }
__host__ __device__ __forceinline__ int perm32(int rho) { const int n = rho >> 4, i = rho & 15; return 8 * (i >> 2) + 4 * n + (i & 3); }

struct Unit { int pm, pn; };
struct Gemm { const bf16_t* A; const bf16_t* Bt; int lda, K, grp; };

struct StaticOrder {
    int nM, nN, nwg, G, c;
    __host__ __device__ void init(int nM_, int nN_, int G_, int c_) { nM = nM_; nN = nN_; nwg = nM * nN; G = G_; c = c_; }
    __host__ __device__ bool next(int i, Unit& u) const {
        const long L = (long)i * G + c; if (L >= nwg) return false;
        int wgid = (int)L; { const int q = nwg / NXCD, r = nwg % NXCD, xcd = wgid % NXCD, off = wgid / NXCD; wgid = (xcd < r ? xcd * (q + 1) : r * (q + 1) + (xcd - r) * q) + off; }
        const int nig = WGM * nN, gid = wgid / nig, fm = gid * WGM, gsz = (nM - fm) < WGM ? (nM - fm) : WGM;
        u.pm = fm + ((wgid % nig) % gsz); u.pn = (wgid % nig) / gsz; return true;
    }
};

__device__ __forceinline__ unsigned cvt_pk_bf16(float lo, float hi) { unsigned r; asm volatile("v_cvt_pk_bf16_f32 %0, %1, %2" : "=v"(r) : "v"(lo), "v"(hi)); return r; }

constexpr int DM = 2048, DFF = 5632, NSS = 32;

__device__ __forceinline__ float row_rs(const float* SS, int row, int fq) {
    const f32x4 p0 = *(const f32x4*)(SS + (size_t)row * NSS + fq * 8), p1 = *(const f32x4*)(SS + (size_t)row * NSS + fq * 8 + 4);
    float s = ((p0[0] + p0[1]) + (p0[2] + p0[3])) + ((p1[0] + p1[1]) + (p1[2] + p1[3]));
    s += __shfl_xor(s, 16); s += __shfl_xor(s, 32);
    return 1.0f / sqrtf(s * (1.0f / DM) + 1e-6f);
}

struct EpiConvIn {
    static constexpr bool PERM = true;
    bf16_t* Bb; bf16_t* Uu;
    __device__ __forceinline__ void operator()(const f32x4 (&acc)[2][2][4][2], const Unit& u, int wr, int wc, int fr, int fq) const {
        const int row0 = u.pm * BM + wr * 64 + fr;
        if (u.pn < 8) {
            const int col0 = u.pn * BM + wc * 32 + 8 * fq;
#pragma unroll
            for (int ai = 0; ai < 2; ++ai)
#pragma unroll
                for (int m = 0; m < 4; ++m) { bf16_t* rowp = Bb + (size_t)(row0 + ai * HALF + m * 16) * DM + col0;
#pragma unroll
                    for (int bj = 0; bj < 2; ++bj) { const f32x4 v0 = acc[ai][bj][m][0], v1 = acc[ai][bj][m][1];
                        u32x4 w; w.x = cvt_pk_bf16(v0[0], v0[1]); w.y = cvt_pk_bf16(v0[2], v0[3]); w.z = cvt_pk_bf16(v1[0], v1[1]); w.w = cvt_pk_bf16(v1[2], v1[3]);
                        *(u32x4*)(rowp + bj * HALF) = w; } }
        } else {
            const int col0 = (u.pn - 8) * HALF + wc * 32 + 8 * fq;
#pragma unroll
            for (int ai = 0; ai < 2; ++ai)
#pragma unroll
                for (int m = 0; m < 4; ++m) { bf16_t* rowp = Uu + (size_t)(row0 + ai * HALF + m * 16) * DM + col0;
                    const f32x4 v0 = acc[ai][0][m][0] * acc[ai][1][m][0], v1 = acc[ai][0][m][1] * acc[ai][1][m][1];
                    u32x4 w; w.x = cvt_pk_bf16(v0[0], v0[1]); w.y = cvt_pk_bf16(v0[2], v0[3]); w.z = cvt_pk_bf16(v1[0], v1[1]); w.w = cvt_pk_bf16(v1[2], v1[3]);
                    *(u32x4*)rowp = w; }
        }
    }
};
__device__ __forceinline__ float silu_mul(float g, float u) { return g * __builtin_amdgcn_rcpf(1.0f + __expf(-g)) * u; }
struct EpiGateUp {
    static constexpr bool PERM = true;
    bf16_t* Act; const float* SS;
    __device__ __forceinline__ void operator()(const f32x4 (&acc)[2][2][4][2], const Unit& u, int wr, int wc, int fr, int fq) const {
        const int row0 = u.pm * BM + wr * 64 + fr, col0 = u.pn * HALF + wc * 32 + 8 * fq;
#pragma unroll
        for (int ai = 0; ai < 2; ++ai)
#pragma unroll
            for (int m = 0; m < 4; ++m) { const int row = row0 + ai * HALF + m * 16; const float rs = row_rs(SS, row, fq);
                f32x4 a0, a1;
#pragma unroll
                for (int j = 0; j < 4; ++j) { a0[j] = silu_mul(acc[ai][0][m][0][j] * rs, acc[ai][1][m][0][j] * rs); a1[j] = silu_mul(acc[ai][0][m][1][j] * rs, acc[ai][1][m][1][j] * rs); }
                u32x4 w; w.x = cvt_pk_bf16(a0[0], a0[1]); w.y = cvt_pk_bf16(a0[2], a0[3]); w.z = cvt_pk_bf16(a1[0], a1[1]); w.w = cvt_pk_bf16(a1[2], a1[3]);
                *(u32x4*)(Act + (size_t)row * DFF + col0) = w; }
    }
};
template <bool HAS_SCALE, bool HAS_OUT> struct EpiRes {
    static constexpr bool PERM = true;
    float* H; const float* cscale; const float* gvec; bf16_t* Xo; float* SS;
    __device__ __forceinline__ void operator()(const f32x4 (&acc)[2][2][4][2], const Unit& u, int wr, int wc, int fr, int fq) const {
        const int row0 = u.pm * BM + wr * 64 + fr, col0 = u.pn * BM + wc * 32 + 8 * fq;
        f32x4 cs[2][2], gv[2][2];
#pragma unroll
        for (int bj = 0; bj < 2; ++bj)
#pragma unroll
            for (int n = 0; n < 2; ++n) { cs[bj][n] = HAS_SCALE ? *(const f32x4*)(cscale + col0 + bj * HALF + 4 * n) : (f32x4){1.f, 1.f, 1.f, 1.f};
                                          gv[bj][n] = HAS_OUT ? *(const f32x4*)(gvec + col0 + bj * HALF + 4 * n) : (f32x4){1.f, 1.f, 1.f, 1.f}; }
#pragma unroll
        for (int ai = 0; ai < 2; ++ai)
#pragma unroll
            for (int m = 0; m < 4; ++m) { const int row = row0 + ai * HALF + m * 16; float* hp = H + (size_t)row * DM + col0; float ssq = 0.f;
#pragma unroll
                for (int bj = 0; bj < 2; ++bj) { f32x4 h0 = *(const f32x4*)(hp + bj * HALF), h1 = *(const f32x4*)(hp + bj * HALF + 4);
                    if (HAS_SCALE) { h0 += acc[ai][bj][m][0] * cs[bj][0]; h1 += acc[ai][bj][m][1] * cs[bj][1]; } else { h0 += acc[ai][bj][m][0]; h1 += acc[ai][bj][m][1]; }
                    *(f32x4*)(hp + bj * HALF) = h0; *(f32x4*)(hp + bj * HALF + 4) = h1;
                    ssq += ((h0[0] * h0[0] + h0[1] * h0[1]) + (h0[2] * h0[2] + h0[3] * h0[3])) + ((h1[0] * h1[0] + h1[1] * h1[1]) + (h1[2] * h1[2] + h1[3] * h1[3]));
                    if (HAS_OUT) { const f32x4 g0 = h0 * gv[bj][0], g1 = h1 * gv[bj][1];
                        u32x4 w; w.x = cvt_pk_bf16(g0[0], g0[1]); w.y = cvt_pk_bf16(g0[2], g0[3]); w.z = cvt_pk_bf16(g1[0], g1[1]); w.w = cvt_pk_bf16(g1[2], g1[3]);
                        *(u32x4*)(Xo + (size_t)row * DM + col0 + bj * HALF) = w; } }
                ssq += __shfl_xor(ssq, 16); ssq += __shfl_xor(ssq, 32);
                if (fq == 0) SS[(size_t)row * NSS + u.pn * 4 + wc] = ssq;
                asm volatile("" ::: "memory"); }
    }
};

template <class Epi, class Sched, bool ALIGN_EPI = false, bool SP2 = false>
__device__ __forceinline__ void gemm_phase(PG8_LAS unsigned char* lds, const Gemm g, const Sched& S, const Epi& E) {
    const int tid = threadIdx.x, wid = __builtin_amdgcn_readfirstlane(tid >> 6), lane = tid & 63, wr = wid >> 2, wc = wid & 3, fr = lane & 15, fq = lane >> 4;
    const int K = g.K, nt = K / BK, lda = g.lda;
    unsigned voffA[2], voffB[2];
#pragma unroll
    for (int i = 0; i < 2; ++i) { int R, C; stage_rc(tid * 16 + i * 8192, R, C); const int Rb = Epi::PERM ? ((R & ~31) + perm32(R & 31)) : R;
        voffA[i] = (unsigned)(R * lda + C) * 2u; voffB[i] = (unsigned)(Rb * K + C) * 2u; }
    const size_t kstep = (size_t)(BK * 2);
    const size_t hstepA = (size_t)HALF * lda * 2, hstepB = (size_t)HALF * K * 2;
    const size_t tstepA = 2 * hstepA, tstepB = 2 * hstepB;
    const unsigned ldsw = (unsigned)wid * 1024u;
    const int aoff = lds_byte(wr * 64 + fr, fq * 8), boff = lds_byte(wc * 32 + fr, fq * 8);
#define PG8_SA(b, h) (((b) * 2 + (h)) * HTB)
#define PG8_SB(b, h) ((4 + (b) * 2 + (h)) * HTB)
#define PG8_STAGE(bufoff, gbase, voff) do { _Pragma("unroll") for (int _i = 0; _i < 2; ++_i) \
        __builtin_amdgcn_global_load_lds((const unsigned*)((const char*)(gbase) + (voff)[_i]), (PG8_LAS unsigned*)(lds + (bufoff) + ldsw + _i * 8192), 16, 0, 0); } while (0)
#define PG8_LDA(dst, b, h) do { _Pragma("unroll") for (int m = 0; m < 4; ++m) _Pragma("unroll") for (int k = 0; k < 2; ++k) dst[m][k] = *(const PG8_LAS bf16x8*)(lds + PG8_SA(b, h) + aoff + m * 2048 + k * 1024); } while (0)
#define PG8_LDB(dst, b, h) do { _Pragma("unroll") for (int n = 0; n < 2; ++n) _Pragma("unroll") for (int k = 0; k < 2; ++k) dst[n][k] = *(const PG8_LAS bf16x8*)(lds + PG8_SB(b, h) + boff + n * 2048 + k * 1024); } while (0)
#define PG8_MMA(ai, bj, At, Bt) do { __builtin_amdgcn_s_setprio(1); _Pragma("unroll") for (int m = 0; m < 4; ++m) _Pragma("unroll") for (int n = 0; n < 2; ++n) _Pragma("unroll") for (int k = 0; k < 2; ++k) \
        acc[ai][bj][m][n] = __builtin_amdgcn_mfma_f32_16x16x32_bf16(Bt[n][k], At[m][k], acc[ai][bj][m][n], 0, 0, 0); __builtin_amdgcn_s_setprio(0); } while (0)
#define PG8_WAIT_V(n) asm volatile("s_waitcnt vmcnt(" #n ")" ::: "memory")
#define PG8_WAIT_L(n) asm volatile("s_waitcnt lgkmcnt(" #n ")" ::: "memory")
#define PG8_BAR __builtin_amdgcn_s_barrier()
#define PG8_SCHED __builtin_amdgcn_sched_barrier(0)
#define PG8_AOFF(u_) ((size_t)(u_).pm * tstepA + (g.grp ? (size_t)((u_).pn / g.grp) * (size_t)K * 2 : (size_t)0))
    Unit cur, nxt; int ui = 0;
    if (!S.next(0, cur)) return;
    f32x4 acc[2][2][4][2];
#pragma unroll
    for (int a = 0; a < 2; ++a)
#pragma unroll
        for (int b = 0; b < 2; ++b)
#pragma unroll
            for (int m = 0; m < 4; ++m)
#pragma unroll
                for (int n = 0; n < 2; ++n) acc[a][b][m][n] = (f32x4){0.f, 0.f, 0.f, 0.f};
    bf16x8 At[4][2], B0[2][2], B1[2][2];
    const char* cA = (const char*)g.A + PG8_AOFF(cur); const char* cB = (const char*)g.Bt + (size_t)cur.pn * tstepB;
    if constexpr (SP2) {
        PG8_STAGE(PG8_SB(0, 0), cB, voffB); PG8_STAGE(PG8_SB(0, 1), cB + hstepB, voffB); PG8_STAGE(PG8_SA(0, 0), cA, voffA); PG8_STAGE(PG8_SA(0, 1), cA + hstepA, voffA);
        if (wr == 1) PG8_BAR;
        PG8_WAIT_V(2); PG8_BAR;
        PG8_STAGE(PG8_SB(1, 0), cB + kstep, voffB); PG8_STAGE(PG8_SA(1, 0), cA + kstep, voffA); PG8_STAGE(PG8_SB(1, 1), cB + hstepB + kstep, voffB);
        PG8_WAIT_V(6); PG8_BAR;
    } else {
        PG8_STAGE(PG8_SB(0, 0), cB, voffB); PG8_STAGE(PG8_SA(0, 0), cA, voffA); PG8_STAGE(PG8_SB(0, 1), cB + hstepB, voffB); PG8_STAGE(PG8_SA(0, 1), cA + hstepA, voffA);
        if (wr == 1) PG8_BAR;
        PG8_WAIT_V(4); PG8_BAR;
        PG8_STAGE(PG8_SB(1, 0), cB + kstep, voffB); PG8_STAGE(PG8_SA(1, 0), cA + kstep, voffA); PG8_STAGE(PG8_SB(1, 1), cB + hstepB + kstep, voffB);
        PG8_WAIT_V(6); PG8_BAR;
    }
    for (;;) {
        const bool has_next = S.next(ui + 1, nxt);
        const char* nA = has_next ? (const char*)g.A + PG8_AOFF(nxt) : cA; const char* nB = has_next ? (const char*)g.Bt + (size_t)nxt.pn * tstepB : cB;
        for (int t = 0; t < nt; t += 2) {
            const bool last = (t == nt - 2);
            const char* a1 = cA + (size_t)(t + 1) * kstep;
            const char* a2 = last ? nA : cA + (size_t)(t + 2) * kstep; const char* b2 = last ? nB : cB + (size_t)(t + 2) * kstep;
            const char* a3 = a2 + kstep; const char* b3 = b2 + kstep;
            if constexpr (SP2) {
            PG8_LDB(B0, 0, 0); PG8_LDB(B1, 0, 1); PG8_SCHED; PG8_LDA(At, 0, 0); PG8_STAGE(PG8_SA(1, 1), a1 + hstepA, voffA);
            PG8_WAIT_V(8); PG8_WAIT_L(0); PG8_BAR; PG8_MMA(0, 0, At, B0); PG8_MMA(0, 1, At, B1); PG8_BAR; PG8_SCHED;
            PG8_LDA(At, 0, 1); PG8_STAGE(PG8_SB(0, 0), b2, voffB); PG8_STAGE(PG8_SB(0, 1), b2 + hstepB, voffB); PG8_STAGE(PG8_SA(0, 0), a2, voffA);
            PG8_WAIT_V(8); PG8_WAIT_L(0); PG8_BAR; PG8_MMA(1, 0, At, B0); PG8_MMA(1, 1, At, B1); PG8_BAR; PG8_SCHED;
            PG8_LDB(B0, 1, 0); PG8_LDB(B1, 1, 1); PG8_SCHED; PG8_LDA(At, 1, 0); PG8_STAGE(PG8_SA(0, 1), a2 + hstepA, voffA);
            PG8_WAIT_V(8); PG8_WAIT_L(0); PG8_BAR; PG8_MMA(0, 0, At, B0); PG8_MMA(0, 1, At, B1); PG8_BAR; PG8_SCHED;
            PG8_LDA(At, 1, 1); PG8_STAGE(PG8_SB(1, 0), b3, voffB); PG8_STAGE(PG8_SB(1, 1), b3 + hstepB, voffB); PG8_STAGE(PG8_SA(1, 0), a3, voffA);
            PG8_WAIT_V(8); PG8_WAIT_L(0); PG8_BAR; PG8_MMA(1, 0, At, B0); PG8_MMA(1, 1, At, B1); PG8_BAR; PG8_SCHED;
            } else {
            PG8_LDB(B0, 0, 0); PG8_SCHED; PG8_LDA(At, 0, 0); PG8_STAGE(PG8_SA(1, 1), a1 + hstepA, voffA);
            PG8_WAIT_L(8); PG8_BAR; PG8_WAIT_L(0); PG8_MMA(0, 0, At, B0); PG8_BAR; PG8_SCHED;
            PG8_LDB(B1, 0, 1); PG8_STAGE(PG8_SB(0, 0), b2, voffB);
            PG8_BAR; PG8_WAIT_L(0); PG8_MMA(0, 1, At, B1); PG8_BAR;
            PG8_LDA(At, 0, 1); PG8_STAGE(PG8_SA(0, 0), a2, voffA);
            PG8_BAR; PG8_WAIT_L(0); PG8_MMA(1, 0, At, B0); PG8_BAR; PG8_SCHED;
            PG8_STAGE(PG8_SB(0, 1), b2 + hstepB, voffB);
            PG8_WAIT_V(6); PG8_BAR; PG8_MMA(1, 1, At, B1); PG8_BAR;
            PG8_LDB(B0, 1, 0); PG8_SCHED; PG8_LDA(At, 1, 0); PG8_STAGE(PG8_SA(0, 1), a2 + hstepA, voffA);
            PG8_WAIT_L(8); PG8_BAR; PG8_WAIT_L(0); PG8_MMA(0, 0, At, B0); PG8_BAR; PG8_SCHED;
            PG8_LDB(B1, 1, 1); PG8_STAGE(PG8_SB(1, 0), b3, voffB);
            PG8_BAR; PG8_WAIT_L(0); PG8_MMA(0, 1, At, B1); PG8_BAR;
            PG8_LDA(At, 1, 1); PG8_STAGE(PG8_SA(1, 0), a3, voffA);
            PG8_BAR; PG8_WAIT_L(0); PG8_MMA(1, 0, At, B0); PG8_BAR; PG8_SCHED;
            PG8_STAGE(PG8_SB(1, 1), b3 + hstepB, voffB);
            PG8_WAIT_V(6); PG8_BAR; PG8_MMA(1, 1, At, B1); PG8_BAR;
            }
        }
        if constexpr (ALIGN_EPI) { if (wr == 0) PG8_BAR; }
        E(acc, cur, wr, wc, fr, fq);
        if (!has_next) break;
#pragma unroll
        for (int a = 0; a < 2; ++a)
#pragma unroll
            for (int b = 0; b < 2; ++b)
#pragma unroll
                for (int m = 0; m < 4; ++m)
#pragma unroll
                    for (int n = 0; n < 2; ++n) acc[a][b][m][n] = (f32x4){0.f, 0.f, 0.f, 0.f};
        cur = nxt; cA = nA; cB = nB; ++ui;
        if constexpr (ALIGN_EPI) { if (wr == 1) PG8_BAR; }
    }
    PG8_WAIT_V(0);
    if constexpr (!ALIGN_EPI) { if (wr == 0) PG8_BAR; }
    PG8_BAR;
#undef PG8_AOFF
#undef PG8_SA
#undef PG8_SB
#undef PG8_STAGE
#undef PG8_LDA
#undef PG8_LDB
#undef PG8_MMA
#undef PG8_WAIT_V
#undef PG8_WAIT_L
#undef PG8_BAR
#undef PG8_SCHED
}
}

#ifndef PG8_SP2
#define PG8_SP2 true
#endif
#ifndef PG8_ALIGN
#define PG8_ALIGN true
#endif

constexpr int NWAVES = 8;
constexpr int D = 2048, FF = 5632, BATCH = 4, SEQ = 2048, NMETA = 16, TP = SEQ + NMETA  , DEC_B = 128, DEC_T = 8;
constexpr int MPROMPT = BATCH * TP  , MSAMPLE = DEC_B * DEC_T  , MREAL = MPROMPT + MSAMPLE  , MP = 9472  , NMT = MP / 256;
constexpr int PHIST = 15, NSS = pg8::NSS;
constexpr float EPS = 1e-6f;
static_assert(MP % 256 == 0 && MP >= MREAL, "row padding");
constexpr size_t O_YP = 0, O_YS = O_YP + (size_t)BATCH * SEQ * D, O_NCP = O_YS + (size_t)MSAMPLE * D, O_NPP = O_NCP + (size_t)BATCH * 2 * D,
                 O_NCS = O_NPP + (size_t)BATCH * PHIST * D, O_NPS = O_NCS + (size_t)DEC_B * 2 * D, O_END = O_NPS + (size_t)DEC_B * PHIST * D;
constexpr size_t MiB = 1u << 20;
constexpr size_t WS_WIN = 0;
constexpr size_t WS_WOUT = 24 * MiB;
constexpr size_t WS_WPOOL = 32 * MiB;
constexpr size_t WS_WGU = 34 * MiB;
constexpr size_t WS_WDN = 122 * MiB;
constexpr size_t WS_XA = 166 * MiB, WS_XB = 203 * MiB;
constexpr size_t WS_BB = 240 * MiB, WS_UU = 277 * MiB;
constexpr size_t WS_H = 314 * MiB;
constexpr size_t WS_ACT = 388 * MiB;
constexpr size_t WS_SS = 490 * MiB;
constexpr size_t WS_END = 492 * MiB;
static_assert((size_t)MP * D * 2 <= 37 * MiB && (size_t)MP * D * 4 <= 74 * MiB && (size_t)MP * FF * 2 <= 102 * MiB, "ws map");
constexpr int LDS_BYTES = 147456;

#define GAS __attribute__((address_space(1)))
#define LAS __attribute__((address_space(3)))
typedef unsigned short bf16;
typedef unsigned v4u __attribute__((ext_vector_type(4)));
typedef unsigned v2u __attribute__((ext_vector_type(2)));
typedef float f32x4 __attribute__((ext_vector_type(4)));
#define LDS_WAIT() asm volatile("s_waitcnt lgkmcnt(0)" ::: "memory")
__device__ __forceinline__ unsigned f2bf(float f) { unsigned u = __builtin_bit_cast(unsigned, f); return (u + 0x7fffu + ((u >> 16) & 1u)) >> 16; }
__device__ __forceinline__ unsigned pk2(float lo, float hi) { return f2bf(lo) | (f2bf(hi) << 16); }
__device__ __forceinline__ float bf_lo(unsigned w) { return __builtin_bit_cast(float, w << 16); }
__device__ __forceinline__ float bf_hi(unsigned w) { return __builtin_bit_cast(float, w & 0xffff0000u); }
__device__ __forceinline__ float wave_sum(float v) {
#pragma unroll
    for (int o = 1; o < 64; o <<= 1) v += __shfl_xor(v, o);
    return v;
}

struct Args {
    const float *x_prompt, *x_sample, *state_conv, *state_pool, *meta, *norm_mix, *norm_ffn, *norm_final, *w_in, *w_dw, *w_out, *pool_w, *pool_scale, *w_gu, *w_dn;
    float* out; unsigned char* ws;
};

__device__ __forceinline__ void p0_transpose_item(const float* W, int K, int N, bf16* WT, int drow0, LAS float* scr, int k0, int n0, int lane) {
#pragma unroll 8
    for (int i = 0; i < 32; ++i) { const int kk = 2 * i + (lane >> 5); scr[kk * 33 + (lane & 31)] = W[(size_t)(k0 + kk) * N + n0 + (lane & 31)]; }
    LDS_WAIT(); asm volatile("" ::: "memory");
    const int c = lane & 7;
#pragma unroll
    for (int j = 0; j < 4; ++j) { const int n = (lane >> 3) + 8 * j; const LAS float* s = scr + (8 * c) * 33 + n;
        v4u o; o.x = pk2(s[0 * 33], s[1 * 33]); o.y = pk2(s[2 * 33], s[3 * 33]); o.z = pk2(s[4 * 33], s[5 * 33]); o.w = pk2(s[6 * 33], s[7 * 33]);
        *(GAS v4u*)(WT + (size_t)(drow0 + n) * K + k0 + 8 * c) = o; }
    LDS_WAIT(); asm volatile("" ::: "memory");
}
__device__ __forceinline__ int pair_row(int n0, int NH) { const int s = n0 >= NH ? 1 : 0, j = n0 - s * NH; return (j >> 7) * 256 + s * 128 + (j & 127); }

__device__ __forceinline__ const float* x_row(const Args& a, int r) {
    if (r < MPROMPT) { const int b = r / TP, t = r - b * TP; return t < NMETA ? a.meta + (size_t)t * D : a.x_prompt + ((size_t)b * SEQ + (t - NMETA)) * D; }
    if (r < MREAL) return a.x_sample + (size_t)(r - MPROMPT) * D;
    return nullptr;
}

__global__ void __launch_bounds__(NWAVES * 64, 2) fwd_mega(Args a) {
    extern __shared__ __attribute__((aligned(16))) unsigned char lds_raw[];
    cg::grid_group grid = cg::this_grid();
    LAS unsigned char* lds = (LAS unsigned char*)lds_raw;
    const int tid = threadIdx.x, lane = tid & 63, wave = __builtin_amdgcn_readfirstlane(tid >> 6);
    const int G = gridDim.x; const int bx = blockIdx.x;
    const int vcu = (G % 8 == 0) ? (bx % 8) * (G / 8) + bx / 8 : bx;
    const int gw = vcu * NWAVES + wave, NGW = G * NWAVES;
    unsigned char* ws = a.ws;
    bf16* Win_t = (bf16*)(ws + WS_WIN); bf16* Wout_t = (bf16*)(ws + WS_WOUT); bf16* Wpool_t = (bf16*)(ws + WS_WPOOL);
    bf16* Wgu_t = (bf16*)(ws + WS_WGU); bf16* Wdn_t = (bf16*)(ws + WS_WDN);
    bf16* XA = (bf16*)(ws + WS_XA); bf16* XB = (bf16*)(ws + WS_XB); bf16* BB = (bf16*)(ws + WS_BB); bf16* UU = (bf16*)(ws + WS_UU);
    float* H = (float*)(ws + WS_H); bf16* ACT = (bf16*)(ws + WS_ACT); float* SS = (float*)(ws + WS_SS);

    {
        LAS float* scr = (LAS float*)(lds + wave * 16384);
        constexpr int I_IN = (D / 64) * (3 * D / 32), I_OUT = (D / 64) * (D / 32), I_GU = (D / 64) * (2 * FF / 32), I_DN = (FF / 64) * (D / 32), I_PL = 4 * (512 / 64) * (512 / 32);
        constexpr int NITEMS = I_IN + I_OUT + 2 * I_GU + 2 * I_DN + I_PL;
        for (int it = gw; it < NITEMS; it += NGW) {
            int r = it;
            if (r < I_IN) { const int nblk = 3 * D / 32, k0 = 64 * (r / nblk), n0 = 32 * (r % nblk);
                const int drow = n0 < D ? n0 : D + pair_row(n0 - D, D);
                p0_transpose_item(a.w_in, D, 3 * D, Win_t, drow, scr, k0, n0, lane); continue; } r -= I_IN;
            if (r < I_OUT) { const int nblk = D / 32, k0 = 64 * (r / nblk), n0 = 32 * (r % nblk);
                p0_transpose_item(a.w_out, D, D, Wout_t, n0, scr, k0, n0, lane); continue; } r -= I_OUT;
            if (r < 2 * I_GU) { const int l = r / I_GU; r -= l * I_GU; const int nblk = 2 * FF / 32, k0 = 64 * (r / nblk), n0 = 32 * (r % nblk);
                p0_transpose_item(a.w_gu + (size_t)l * D * 2 * FF, D, 2 * FF, Wgu_t + (size_t)l * 2 * FF * D, pair_row(n0, FF), scr, k0, n0, lane); continue; } r -= 2 * I_GU;
            if (r < 2 * I_DN) { const int l = r / I_DN; r -= l * I_DN; const int nblk = D / 32, k0 = 64 * (r / nblk), n0 = 32 * (r % nblk);
                p0_transpose_item(a.w_dn + (size_t)l * FF * D, FF, D, Wdn_t + (size_t)l * D * FF, n0, scr, k0, n0, lane); continue; } r -= 2 * I_DN;
            { const int gq = r / 128; r -= gq * 128; const int nblk = 512 / 32, k0 = 64 * (r / nblk), n0 = 32 * (r % nblk);
                p0_transpose_item(a.pool_w + (size_t)gq * 512 * 512, 512, 512, Wpool_t + (size_t)gq * 512 * 512, n0, scr, k0, n0, lane); }
        }
        for (int r = gw; r < MP; r += NGW) {
            const float* xr = x_row(a, r);
            GAS f32x4* hrow = (GAS f32x4*)(H + (size_t)r * D) + lane; GAS v2u* orow = (GAS v2u*)(XA + (size_t)r * D) + lane;
            f32x4 v[8]; float s = 0.f;
#pragma unroll
            for (int j = 0; j < 8; ++j) { v[j] = xr ? ((const GAS f32x4*)xr)[lane + 64 * j] : (f32x4){0.f, 0.f, 0.f, 0.f}; s += (v[j][0] * v[j][0] + v[j][1] * v[j][1]) + (v[j][2] * v[j][2] + v[j][3] * v[j][3]); }
            const float rs = 1.0f / sqrtf(wave_sum(s) * (1.0f / D) + EPS);
#pragma unroll
            for (int j = 0; j < 8; ++j) { const f32x4 gm = ((const GAS f32x4*)a.norm_mix)[lane + 64 * j]; const f32x4 o = v[j] * rs * gm;
                hrow[64 * j] = v[j]; v2u w; w.x = pk2(o[0], o[1]); w.y = pk2(o[2], o[3]); orow[64 * j] = w; }
        }
    }
    grid.sync();

    {
        pg8::Gemm g{XA, Win_t, D, D, 0}; pg8::StaticOrder S; S.init(NMT, 3 * D / 256, G, bx);
        pg8::EpiConvIn E{BB, UU};
        pg8::gemm_phase<pg8::EpiConvIn, pg8::StaticOrder, PG8_ALIGN, PG8_SP2>(lds, g, S, E);
    }
    grid.sync();

    for (int r = gw; r < MREAL; r += NGW) {
        const bool smp = r >= MPROMPT; const int rr = smp ? r - MPROMPT : r; const int b = smp ? rr / DEC_T : rr / TP; const int t = smp ? rr - b * DEC_T : rr - b * TP; const int T = smp ? DEC_T : TP;
        const float* hist = a.state_conv + (size_t)b * 2 * D;
#pragma unroll
        for (int j = 0; j < 4; ++j) {
            const int c = j * 512 + lane * 8;
            const v4u bb = *(const GAS v4u*)(BB + (size_t)r * D + c), u0 = *(const GAS v4u*)(UU + (size_t)r * D + c);
            float u0f[8], u1f[8], u2f[8], bf[8];
#pragma unroll
            for (int q = 0; q < 4; ++q) { u0f[2 * q] = bf_lo(u0[q]); u0f[2 * q + 1] = bf_hi(u0[q]); bf[2 * q] = bf_lo(bb[q]); bf[2 * q + 1] = bf_hi(bb[q]); }
            if (t >= 1) { const v4u w = *(const GAS v4u*)(UU + (size_t)(r - 1) * D + c);
#pragma unroll
                for (int q = 0; q < 4; ++q) { u1f[2 * q] = bf_lo(w[q]); u1f[2 * q + 1] = bf_hi(w[q]); } }
            else if (smp) { const f32x4 h0 = *(const GAS f32x4*)(hist + D + c), h1 = *(const GAS f32x4*)(hist + D + c + 4);
#pragma unroll
                for (int q = 0; q < 4; ++q) { u1f[q] = h0[q]; u1f[4 + q] = h1[q]; } }
            else {
#pragma unroll
                for (int q = 0; q < 8; ++q) u1f[q] = 0.f; }
            if (t >= 2) { const v4u w = *(const GAS v4u*)(UU + (size_t)(r - 2) * D + c);
#pragma unroll
                for (int q = 0; q < 4; ++q) { u2f[2 * q] = bf_lo(w[q]); u2f[2 * q + 1] = bf_hi(w[q]); } }
            else if (smp) { const f32x4 h0 = *(const GAS f32x4*)(hist + (size_t)t * D + c), h1 = *(const GAS f32x4*)(hist + (size_t)t * D + c + 4);
#pragma unroll
                for (int q = 0; q < 4; ++q) { u2f[q] = h0[q]; u2f[4 + q] = h1[q]; } }
            else {
#pragma unroll
                for (int q = 0; q < 8; ++q) u2f[q] = 0.f; }
            float o[8];
#pragma unroll
            for (int h = 0; h < 2; ++h) { const f32x4 w0 = *(const GAS f32x4*)(a.w_dw + c + 4 * h), w1 = *(const GAS f32x4*)(a.w_dw + D + c + 4 * h), w2 = *(const GAS f32x4*)(a.w_dw + 2 * D + c + 4 * h);
#pragma unroll
                for (int q = 0; q < 4; ++q) { const int e = 4 * h + q; o[e] = bf[e] * (w0[q] * u2f[e] + w1[q] * u1f[e] + w2[q] * u0f[e]); } }
            v4u w; w.x = pk2(o[0], o[1]); w.y = pk2(o[2], o[3]); w.z = pk2(o[4], o[5]); w.w = pk2(o[6], o[7]);
            *(GAS v4u*)(XB + (size_t)r * D + c) = w;
            if (t >= T - 2) { float* dst = a.out + (smp ? O_NCS : O_NCP) + ((size_t)b * 2 + (t - (T - 2))) * D + c;
                *(GAS f32x4*)dst = (f32x4){u0f[0], u0f[1], u0f[2], u0f[3]}; *(GAS f32x4*)(dst + 4) = (f32x4){u0f[4], u0f[5], u0f[6], u0f[7]}; }
        }
    }
    grid.sync();

    {
        pg8::Gemm g{XB, Wout_t, D, D, 0}; pg8::StaticOrder S; S.init(NMT, D / 256, G, bx);
        pg8::EpiRes<false, true> E{H, nullptr, a.norm_ffn, XA, SS};
        pg8::gemm_phase<pg8::EpiRes<false, true>, pg8::StaticOrder, PG8_ALIGN, PG8_SP2>(lds, g, S, E);
    }
    grid.sync();

    {
        pg8::Gemm g{XA, Wgu_t, D, D, 0}; pg8::StaticOrder S; S.init(NMT, 2 * FF / 256, G, bx);
        pg8::EpiGateUp E{ACT, SS};
        pg8::gemm_phase<pg8::EpiGateUp, pg8::StaticOrder, PG8_ALIGN, PG8_SP2>(lds, g, S, E);
    }
    grid.sync();

    {
        pg8::Gemm g{ACT, Wdn_t, FF, FF, 0}; pg8::StaticOrder S; S.init(NMT, D / 256, G, bx);
        pg8::EpiRes<false, false> E{H, nullptr, nullptr, nullptr, SS};
        pg8::gemm_phase<pg8::EpiRes<false, false>, pg8::StaticOrder, PG8_ALIGN, PG8_SP2>(lds, g, S, E);
    }
    grid.sync();

    {
        constexpr int CH = 8;
        constexpr int NCH_P = TP / CH  , ITEMS_P = BATCH * NCH_P * 8, ITEMS = ITEMS_P + DEC_B * 8;
        static_assert(TP % CH == 0 && DEC_T == CH, "pool chunking");
        for (int it = gw; it < ITEMS; it += NGW) {
            const int cs = it & 7, seq_chunk = it >> 3;
            const bool smp = it >= ITEMS_P;
            const int b = smp ? seq_chunk - BATCH * NCH_P : seq_chunk / NCH_P, t0 = smp ? 0 : (seq_chunk - b * NCH_P) * CH;
            const int base = smp ? MPROMPT + b * DEC_T : b * TP;
            const int c0 = cs * 256 + lane * 4, gi = cs >> 1, W = 2 << gi;
            const float* hist = a.state_pool + (size_t)b * PHIST * D;
            float rsv = 0.f;
            { const int t = t0 - 15 + lane; if (lane < CH + 15 && t >= 0) { const float* p = SS + (size_t)(base + t) * NSS; float s = 0.f;
#pragma unroll
                for (int q = 0; q < 8; ++q) { const f32x4 v = *(const GAS f32x4*)(p + 4 * q); s += (v[0] + v[1]) + (v[2] + v[3]); }
                rsv = 1.0f / sqrtf(s * (1.0f / D) + EPS); } }
            const f32x4 gm = *(const GAS f32x4*)(a.norm_mix + D + c0);
            f32x4 nv[CH + 15];
#pragma unroll
            for (int i = 0; i < CH + 15; ++i) { const int t = t0 - 15 + i; f32x4 v = (f32x4){0.f, 0.f, 0.f, 0.f};
                const float rsi = __shfl(rsv, i);
                if (i >= 16 - W) {
                    if (t >= 0) v = *(const GAS f32x4*)(H + (size_t)(base + t) * D + c0) * gm * rsi;
                    else if (smp) v = *(const GAS f32x4*)(hist + (size_t)(t + PHIST) * D + c0); }
                nv[i] = v; }
            f32x4 S4 = (f32x4){0.f, 0.f, 0.f, 0.f};
#pragma unroll
            for (int i = 0; i < 15; ++i) if (i >= 16 - W) S4 += nv[i];
#pragma unroll
            for (int k = 0; k < CH; ++k) { const int t = t0 + k; const f32x4 nt = nv[15 + k]; S4 += nt;
                const float cnt = smp ? (float)W : fminf((float)W, (float)(t + 1));
                const f32x4 p = S4 / cnt - nt;
                v2u w; w.x = pk2(p[0], p[1]); w.y = pk2(p[2], p[3]); *(GAS v2u*)(XB + (size_t)(base + t) * D + c0) = w;
                f32x4 old = nv[k];
                if (W == 8) old = nv[k + 8]; else if (W == 4) old = nv[k + 12]; else if (W == 2) old = nv[k + 14];
                S4 -= old;
                if (smp) *(GAS f32x4*)(a.out + O_NPS + ((size_t)b * PHIST + 7 + t) * D + c0) = nt;
                else if (t >= TP - PHIST) *(GAS f32x4*)(a.out + O_NPP + ((size_t)b * PHIST + (t - (TP - PHIST))) * D + c0) = nt; }
            if (smp) {
#pragma unroll
                for (int k = 0; k < 7; ++k) *(GAS f32x4*)(a.out + O_NPS + ((size_t)b * PHIST + k) * D + c0) = *(const GAS f32x4*)(hist + (size_t)(k + 8) * D + c0); }
        }
    }
    grid.sync();

    {
        pg8::Gemm g{XB, Wpool_t, D, 512, 2}; pg8::StaticOrder S; S.init(NMT, D / 256, G, bx);
        pg8::EpiRes<true, true> E{H, a.pool_scale, a.norm_ffn + D, XA, SS};
        pg8::gemm_phase<pg8::EpiRes<true, true>, pg8::StaticOrder, PG8_ALIGN, PG8_SP2>(lds, g, S, E);
    }
    grid.sync();

    {
        pg8::Gemm g{XA, Wgu_t + (size_t)2 * FF * D, D, D, 0}; pg8::StaticOrder S; S.init(NMT, 2 * FF / 256, G, bx);
        pg8::EpiGateUp E{ACT, SS};
        pg8::gemm_phase<pg8::EpiGateUp, pg8::StaticOrder, PG8_ALIGN, PG8_SP2>(lds, g, S, E);
    }
    grid.sync();

    {
        pg8::Gemm g{ACT, Wdn_t + (size_t)D * FF, FF, FF, 0}; pg8::StaticOrder S; S.init(NMT, D / 256, G, bx);
        pg8::EpiRes<false, false> E{H, nullptr, nullptr, nullptr, SS};
        pg8::gemm_phase<pg8::EpiRes<false, false>, pg8::StaticOrder, PG8_ALIGN, PG8_SP2>(lds, g, S, E);
    }
    grid.sync();

    for (int r = gw; r < MREAL; r += NGW) {
        float* dst;
        if (r < MPROMPT) { const int b = r / TP, t = r - b * TP; if (t < NMETA) continue; dst = a.out + O_YP + ((size_t)b * SEQ + (t - NMETA)) * D; }
        else dst = a.out + O_YS + (size_t)(r - MPROMPT) * D;
        float s = 0.f; { const float v = lane < NSS ? SS[(size_t)r * NSS + lane] : 0.f; s = wave_sum(v); }
        const float rs = 1.0f / sqrtf(s * (1.0f / D) + EPS);
        const GAS f32x4* hrow = (const GAS f32x4*)(H + (size_t)r * D) + lane;
        f32x4 v[8];
#pragma unroll
        for (int j = 0; j < 8; ++j) v[j] = hrow[64 * j];
#pragma unroll
        for (int j = 0; j < 8; ++j) { const f32x4 gm = ((const GAS f32x4*)a.norm_final)[lane + 64 * j]; ((GAS f32x4*)dst)[lane + 64 * j] = v[j] * rs * gm; }
    }
}

extern "C" void kernel_launch(void* const* d_in, const int* in_sizes, int n_in, void* d_out, int out_size, void* d_ws, size_t ws_size, hipStream_t stream) {
    static int grid = 0;
    if (grid == 0) {
        if (n_in != 15 || (size_t)out_size != O_END || ws_size < WS_END) { fprintf(stderr, "kernel_launch: unexpected shapes: n_in %d out %d ws %zu\n", n_in, out_size, ws_size); grid = -1; return; }
        int dev = 0, cus = 0, per_cu = 0;
        if (hipGetDevice(&dev) != hipSuccess || hipDeviceGetAttribute(&cus, hipDeviceAttributeMultiprocessorCount, dev) != hipSuccess) { grid = -1; return; }
        if (hipFuncSetAttribute((const void*)fwd_mega, hipFuncAttributeMaxDynamicSharedMemorySize, LDS_BYTES) != hipSuccess) { fprintf(stderr, "kernel_launch: hipFuncSetAttribute failed\n"); grid = -1; return; }
        if (hipOccupancyMaxActiveBlocksPerMultiprocessor(&per_cu, (const void*)fwd_mega, NWAVES * 64, LDS_BYTES) != hipSuccess || per_cu < 1) { fprintf(stderr, "kernel_launch: occupancy query says %d\n", per_cu); per_cu = 1; }
        (void)hipGetLastError();
        grid = cus * 1;
    }
    if (grid < 0) return;
    Args a{};
    a.x_prompt = (const float*)d_in[0]; a.x_sample = (const float*)d_in[1]; a.state_conv = (const float*)d_in[2]; a.state_pool = (const float*)d_in[3]; a.meta = (const float*)d_in[4];
    a.norm_mix = (const float*)d_in[5]; a.norm_ffn = (const float*)d_in[6]; a.norm_final = (const float*)d_in[7]; a.w_in = (const float*)d_in[8]; a.w_dw = (const float*)d_in[9];
    a.w_out = (const float*)d_in[10]; a.pool_w = (const float*)d_in[11]; a.pool_scale = (const float*)d_in[12]; a.w_gu = (const float*)d_in[13]; a.w_dn = (const float*)d_in[14];
    a.out = (float*)d_out; a.ws = (unsigned char*)d_ws;
    void* args[] = {&a};
    hipError_t e = hipLaunchCooperativeKernel((const void*)fwd_mega, dim3(grid), dim3(NWAVES * 64), args, LDS_BYTES, stream);
    if (e != hipSuccess) fprintf(stderr, "kernel_launch: cooperative launch failed: %s (grid %d)\n", hipGetErrorString(e), grid);
}
```

```cpp
#include <hip/hip_runtime.h>
#include <hip/hip_cooperative_groups.h>
#include <cstdio>
#include <cstdint>
namespace cg = cooperative_groups;

namespace pg8 {
#define PG8_LAS __attribute__((address_space(3)))
typedef unsigned short bf16_t;
typedef short bf16x8 __attribute__((ext_vector_type(8)));
typedef float f32x4 __attribute__((ext_vector_type(4)));
typedef unsigned u32x4 __attribute__((ext_vector_type(4)));
constexpr int BM = 256, BK = 64, HALF = 128, HTB = HALF * BK * 2  , STAGE_BYTES = 8 * HTB, NXCD = 8, WGM = 8;

__host__ __device__ __forceinline__ int lds_byte(int r, int c) { const int st = (r >> 4) * 2 + (c >> 5), rr = r & 15, cc = c & 31, ob = rr * 64 + cc * 2; return st * 1024 + (ob ^ (((ob >> 9) & 1) << 5)); }
__host__ __device__ __forceinline__ void stage_rc(int b, int& R, int& C) { const int st = b / 1024, sb = b % 1024, swz = sb ^ (((sb >> 9) & 1) << 5); R = (st >> 1) * 16 + swz / 64; C = (st & 1) * 32 + (swz % 64) / 2; }
__host__ __device__ __forceinline__ int perm32(int rho) { const int n = rho >> 4, i = rho & 15; return 8 * (i >> 2) + 4 * n + (i & 3); }

struct Unit { int pm, pn; };
struct Gemm { const bf16_t* A; const bf16_t* Bt; int lda, K, grp; };

struct StaticOrder {
    int nM, nN, nwg, G, c;
    __host__ __device__ void init(int nM_, int nN_, int G_, int c_) { nM = nM_; nN = nN_; nwg = nM * nN; G = G_; c = c_; }
    __host__ __device__ bool next(int i, Unit& u) const {
        const long L = (long)i * G + c; if (L >= nwg) return false;
        int wgid = (int)L; { const int q = nwg / NXCD, r = nwg % NXCD, xcd = wgid % NXCD, off = wgid / NXCD; wgid = (xcd < r ? xcd * (q + 1) : r * (q + 1) + (xcd - r) * q) + off; }
        const int nig = WGM * nN, gid = wgid / nig, fm = gid * WGM, gsz = (nM - fm) < WGM ? (nM - fm) : WGM;
        u.pm = fm + ((wgid % nig) % gsz); u.pn = (wgid % nig) / gsz; return true;
    }
};

__device__ __forceinline__ unsigned cvt_pk_bf16(float lo, float hi) { unsigned r; asm volatile("v_cvt_pk_bf16_f32 %0, %1, %2" : "=v"(r) : "v"(lo), "v"(hi)); return r; }

constexpr int DM = 2048, DFF = 5632, NSS = 32;

__device__ __forceinline__ float row_rs(const float* SS, int row, int fq) {
    const f32x4 p0 = *(const f32x4*)(SS + (size_t)row * NSS + fq * 8), p1 = *(const f32x4*)(SS + (size_t)row * NSS + fq * 8 + 4);
    float s = ((p0[0] + p0[1]) + (p0[2] + p0[3])) + ((p1[0] + p1[1]) + (p1[2] + p1[3]));
    s += __shfl_xor(s, 16); s += __shfl_xor(s, 32);
    return 1.0f / sqrtf(s * (1.0f / DM) + 1e-6f);
}

struct EpiConvIn {
    static constexpr bool PERM = true;
    bf16_t* Bb; bf16_t* Uu;
    __device__ __forceinline__ void operator()(const f32x4 (&acc)[2][2][4][2], const Unit& u, int wr, int wc, int fr, int fq) const {
        const int row0 = u.pm * BM + wr * 64 + fr;
        if (u.pn < 8) {
            const int col0 = u.pn * BM + wc * 32 + 8 * fq;
#pragma unroll
            for (int ai = 0; ai < 2; ++ai)
#pragma unroll
                for (int m = 0; m < 4; ++m) { bf16_t* rowp = Bb + (size_t)(row0 + ai * HALF + m * 16) * DM + col0;
#pragma unroll
                    for (int bj = 0; bj < 2; ++bj) { const f32x4 v0 = acc[ai][bj][m][0], v1 = acc[ai][bj][m][1];
                        u32x4 w; w.x = cvt_pk_bf16(v0[0], v0[1]); w.y = cvt_pk_bf16(v0[2], v0[3]); w.z = cvt_pk_bf16(v1[0], v1[1]); w.w = cvt_pk_bf16(v1[2], v1[3]);
                        *(u32x4*)(rowp + bj * HALF) = w; } }
        } else {
            const int col0 = (u.pn - 8) * HALF + wc * 32 + 8 * fq;
#pragma unroll
            for (int ai = 0; ai < 2; ++ai)
#pragma unroll
                for (int m = 0; m < 4; ++m) { bf16_t* rowp = Uu + (size_t)(row0 + ai * HALF + m * 16) * DM + col0;
                    const f32x4 v0 = acc[ai][0][m][0] * acc[ai][1][m][0], v1 = acc[ai][0][m][1] * acc[ai][1][m][1];
                    u32x4 w; w.x = cvt_pk_bf16(v0[0], v0[1]); w.y = cvt_pk_bf16(v0[2], v0[3]); w.z = cvt_pk_bf16(v1[0], v1[1]); w.w = cvt_pk_bf16(v1[2], v1[3]);
                    *(u32x4*)rowp = w; }
        }
    }
};
__device__ __forceinline__ float silu_mul(float g, float u) { return g * __builtin_amdgcn_rcpf(1.0f + __expf(-g)) * u; }
struct EpiGateUp {
    static constexpr bool PERM = true;
    bf16_t* Act; const float* SS;
    __device__ __forceinline__ void operator()(const f32x4 (&acc)[2][2][4][2], const Unit& u, int wr, int wc, int fr, int fq) const {
        const int row0 = u.pm * BM + wr * 64 + fr, col0 = u.pn * HALF + wc * 32 + 8 * fq;
#pragma unroll
        for (int ai = 0; ai < 2; ++ai)
#pragma unroll
            for (int m = 0; m < 4; ++m) { const int row = row0 + ai * HALF + m * 16; const float rs = row_rs(SS, row, fq);
                f32x4 a0, a1;
#pragma unroll
                for (int j = 0; j < 4; ++j) { a0[j] = silu_mul(acc[ai][0][m][0][j] * rs, acc[ai][1][m][0][j] * rs); a1[j] = silu_mul(acc[ai][0][m][1][j] * rs, acc[ai][1][m][1][j] * rs); }
                u32x4 w; w.x = cvt_pk_bf16(a0[0], a0[1]); w.y = cvt_pk_bf16(a0[2], a0[3]); w.z = cvt_pk_bf16(a1[0], a1[1]); w.w = cvt_pk_bf16(a1[2], a1[3]);
                *(u32x4*)(Act + (size_t)row * DFF + col0) = w; }
    }
};
template <bool HAS_SCALE, bool HAS_OUT> struct EpiRes {
    static constexpr bool PERM = true;
    float* H; const float* cscale; const float* gvec; bf16_t* Xo; float* SS;
    __device__ __forceinline__ void operator()(const f32x4 (&acc)[2][2][4][2], const Unit& u, int wr, int wc, int fr, int fq) const {
        const int row0 = u.pm * BM + wr * 64 + fr, col0 = u.pn * BM + wc * 32 + 8 * fq;
        f32x4 cs[2][2], gv[2][2];
#pragma unroll
        for (int bj = 0; bj < 2; ++bj)
#pragma unroll
            for (int n = 0; n < 2; ++n) { cs[bj][n] = HAS_SCALE ? *(const f32x4*)(cscale + col0 + bj * HALF + 4 * n) : (f32x4){1.f, 1.f, 1.f, 1.f};
                                          gv[bj][n] = HAS_OUT ? *(const f32x4*)(gvec + col0 + bj * HALF + 4 * n) : (f32x4){1.f, 1.f, 1.f, 1.f}; }
#pragma unroll
        for (int ai = 0; ai < 2; ++ai)
#pragma unroll
            for (int m = 0; m < 4; ++m) { const int row = row0 + ai * HALF + m * 16; float* hp = H + (size_t)row * DM + col0; float ssq = 0.f;
#pragma unroll
                for (int bj = 0; bj < 2; ++bj) { f32x4 h0 = *(const f32x4*)(hp + bj * HALF), h1 = *(const f32x4*)(hp + bj * HALF + 4);
                    if (HAS_SCALE) { h0 += acc[ai][bj][m][0] * cs[bj][0]; h1 += acc[ai][bj][m][1] * cs[bj][1]; } else { h0 += acc[ai][bj][m][0]; h1 += acc[ai][bj][m][1]; }
                    *(f32x4*)(hp + bj * HALF) = h0; *(f32x4*)(hp + bj * HALF + 4) = h1;
                    ssq += ((h0[0] * h0[0] + h0[1] * h0[1]) + (h0[2] * h0[2] + h0[3] * h0[3])) + ((h1[0] * h1[0] + h1[1] * h1[1]) + (h1[2] * h1[2] + h1[3] * h1[3]));
                    if (HAS_OUT) { const f32x4 g0 = h0 * gv[bj][0], g1 = h1 * gv[bj][1];
                        u32x4 w; w.x = cvt_pk_bf16(g0[0], g0[1]); w.y = cvt_pk_bf16(g0[2], g0[3]); w.z = cvt_pk_bf16(g1[0], g1[1]); w.w = cvt_pk_bf16(g1[2], g1[3]);
                        *(u32x4*)(Xo + (size_t)row * DM + col0 + bj * HALF) = w; } }
                ssq += __shfl_xor(ssq, 16); ssq += __shfl_xor(ssq, 32);
                if (fq == 0) SS[(size_t)row * NSS + u.pn * 4 + wc] = ssq;
                asm volatile("" ::: "memory"); }
    }
};

template <class Epi, class Sched, bool ALIGN_EPI = false, bool SP2 = false>
__device__ __forceinline__ void gemm_phase(PG8_LAS unsigned char* lds, const Gemm g, const Sched& S, const Epi& E) {
    int tid_ = threadIdx.x; asm volatile("" : "+v"(tid_));
    const int tid = tid_, wid = __builtin_amdgcn_readfirstlane(tid >> 6), lane = tid & 63, wr = wid >> 2, wc = wid & 3, fr = lane & 15, fq = lane >> 4;
    const int K = g.K, nt = K / BK, lda = g.lda;
    unsigned voffA[2], voffB[2];
#pragma unroll
    for (int i = 0; i < 2; ++i) { int R, C; stage_rc(tid * 16 + i * 8192, R, C); const int Rb = Epi::PERM ? ((R & ~31) + perm32(R & 31)) : R;
        voffA[i] = (unsigned)(R * lda + C) * 2u; voffB[i] = (unsigned)(Rb * K + C) * 2u; }
    const size_t kstep = (size_t)(BK * 2);
    const size_t hstepA = (size_t)HALF * lda * 2, hstepB = (size_t)HALF * K * 2;
    const size_t tstepA = 2 * hstepA, tstepB = 2 * hstepB;
    const unsigned ldsw = (unsigned)wid * 1024u;
    const int aoff = lds_byte(wr * 64 + fr, fq * 8), boff = lds_byte(wc * 32 + fr, fq * 8);
#define PG8_SA(b, h) (((b) * 2 + (h)) * HTB)
#define PG8_SB(b, h) ((4 + (b) * 2 + (h)) * HTB)
#define PG8_STAGE(bufoff, gbase, voff) do { _Pragma("unroll") for (int _i = 0; _i < 2; ++_i) \
        __builtin_amdgcn_global_load_lds((const unsigned*)((const char*)(gbase) + (voff)[_i]), (PG8_LAS unsigned*)(lds + (bufoff) + ldsw + _i * 8192), 16, 0, 0); } while (0)
#define PG8_LDA(dst, b, h) do { _Pragma("unroll") for (int m = 0; m < 4; ++m) _Pragma("unroll") for (int k = 0; k < 2; ++k) dst[m][k] = *(const PG8_LAS bf16x8*)(lds + PG8_SA(b, h) + aoff + m * 2048 + k * 1024); } while (0)
#define PG8_LDB(dst, b, h) do { _Pragma("unroll") for (int n = 0; n < 2; ++n) _Pragma("unroll") for (int k = 0; k < 2; ++k) dst[n][k] = *(const PG8_LAS bf16x8*)(lds + PG8_SB(b, h) + boff + n * 2048 + k * 1024); } while (0)
#define PG8_MMA(ai, bj, At, Bt) do { __builtin_amdgcn_s_setprio(1); _Pragma("unroll") for (int m = 0; m < 4; ++m) _Pragma("unroll") for (int n = 0; n < 2; ++n) _Pragma("unroll") for (int k = 0; k < 2; ++k) \
        acc[ai][bj][m][n] = __builtin_amdgcn_mfma_f32_16x16x32_bf16(Bt[n][k], At[m][k], acc[ai][bj][m][n], 0, 0, 0); __builtin_amdgcn_s_setprio(0); } while (0)
#define PG8_WAIT_V(n) asm volatile("s_waitcnt vmcnt(" #n ")" ::: "memory")
#define PG8_WAIT_L(n) asm volatile("s_waitcnt lgkmcnt(" #n ")" ::: "memory")
#define PG8_BAR __builtin_amdgcn_s_barrier()
#define PG8_SCHED __builtin_amdgcn_sched_barrier(0)
#define PG8_AOFF(u_) ((size_t)(u_).pm * tstepA + (g.grp ? (size_t)((u_).pn / g.grp) * (size_t)K * 2 : (size_t)0))
    Unit cur, nxt; int ui = 0;
    if (!S.next(0, cur)) return;
    f32x4 acc[2][2][4][2];
#pragma unroll
    for (int a = 0; a < 2; ++a)
#pragma unroll
        for (int b = 0; b < 2; ++b)
#pragma unroll
            for (int m = 0; m < 4; ++m)
#pragma unroll
                for (int n = 0; n < 2; ++n) acc[a][b][m][n] = (f32x4){0.f, 0.f, 0.f, 0.f};
    bf16x8 At[4][2], B0[2][2], B1[2][2];
    const char* cA = (const char*)g.A + PG8_AOFF(cur); const char* cB = (const char*)g.Bt + (size_t)cur.pn * tstepB;
    if constexpr (SP2) {
        PG8_STAGE(PG8_SB(0, 0), cB, voffB); PG8_STAGE(PG8_SB(0, 1), cB + hstepB, voffB); PG8_STAGE(PG8_SA(0, 0), cA, voffA); PG8_STAGE(PG8_SA(0, 1), cA + hstepA, voffA);
        if (wr == 1) PG8_BAR;
        PG8_WAIT_V(2); PG8_BAR;
        PG8_STAGE(PG8_SB(1, 0), cB + kstep, voffB); PG8_STAGE(PG8_SA(1, 0), cA + kstep, voffA); PG8_STAGE(PG8_SB(1, 1), cB + hstepB + kstep, voffB);
        PG8_WAIT_V(6); PG8_BAR;
    } else {
        PG8_STAGE(PG8_SB(0, 0), cB, voffB); PG8_STAGE(PG8_SA(0, 0), cA, voffA); PG8_STAGE(PG8_SB(0, 1), cB + hstepB, voffB); PG8_STAGE(PG8_SA(0, 1), cA + hstepA, voffA);
        if (wr == 1) PG8_BAR;
        PG8_WAIT_V(4); PG8_BAR;
        PG8_STAGE(PG8_SB(1, 0), cB + kstep, voffB); PG8_STAGE(PG8_SA(1, 0), cA + kstep, voffA); PG8_STAGE(PG8_SB(1, 1), cB + hstepB + kstep, voffB);
        PG8_WAIT_V(6); PG8_BAR;
    }
    for (;;) {
        const bool has_next = S.next(ui + 1, nxt);
        const char* nA = has_next ? (const char*)g.A + PG8_AOFF(nxt) : cA; const char* nB = has_next ? (const char*)g.Bt + (size_t)nxt.pn * tstepB : cB;
        for (int t = 0; t < nt; t += 2) {
            const bool last = (t == nt - 2);
            const char* a1 = cA + (size_t)(t + 1) * kstep;
            const char* a2 = last ? nA : cA + (size_t)(t + 2) * kstep; const char* b2 = last ? nB : cB + (size_t)(t + 2) * kstep;
            const char* a3 = a2 + kstep; const char* b3 = b2 + kstep;
            if constexpr (SP2) {
            PG8_LDB(B0, 0, 0); PG8_LDB(B1, 0, 1); PG8_SCHED; PG8_LDA(At, 0, 0); PG8_STAGE(PG8_SA(1, 1), a1 + hstepA, voffA);
            PG8_WAIT_V(8); PG8_WAIT_L(0); PG8_BAR; PG8_MMA(0, 0, At, B0); PG8_MMA(0, 1, At, B1); PG8_BAR; PG8_SCHED;
            PG8_LDA(At, 0, 1); PG8_STAGE(PG8_SB(0, 0), b2, voffB); PG8_STAGE(PG8_SB(0, 1), b2 + hstepB, voffB); PG8_STAGE(PG8_SA(0, 0), a2, voffA);
            PG8_WAIT_V(8); PG8_WAIT_L(0); PG8_BAR; PG8_MMA(1, 0, At, B0); PG8_MMA(1, 1, At, B1); PG8_BAR; PG8_SCHED;
            PG8_LDB(B0, 1, 0); PG8_LDB(B1, 1, 1); PG8_SCHED; PG8_LDA(At, 1, 0); PG8_STAGE(PG8_SA(0, 1), a2 + hstepA, voffA);
            PG8_WAIT_V(8); PG8_WAIT_L(0); PG8_BAR; PG8_MMA(0, 0, At, B0); PG8_MMA(0, 1, At, B1); PG8_BAR; PG8_SCHED;
            PG8_LDA(At, 1, 1); PG8_STAGE(PG8_SB(1, 0), b3, voffB); PG8_STAGE(PG8_SB(1, 1), b3 + hstepB, voffB); PG8_STAGE(PG8_SA(1, 0), a3, voffA);
            PG8_WAIT_V(8); PG8_WAIT_L(0); PG8_BAR; PG8_MMA(1, 0, At, B0); PG8_MMA(1, 1, At, B1); PG8_BAR; PG8_SCHED;
            } else {
            PG8_LDB(B0, 0, 0); PG8_SCHED; PG8_LDA(At, 0, 0); PG8_STAGE(PG8_SA(1, 1), a1 + hstepA, voffA);
            PG8_WAIT_L(8); PG8_BAR; PG8_WAIT_L(0); PG8_MMA(0, 0, At, B0); PG8_BAR; PG8_SCHED;
            PG8_LDB(B1, 0, 1); PG8_STAGE(PG8_SB(0, 0), b2, voffB);
            PG8_BAR; PG8_WAIT_L(0); PG8_MMA(0, 1, At, B1); PG8_BAR;
            PG8_LDA(At, 0, 1); PG8_STAGE(PG8_SA(0, 0), a2, voffA);
            PG8_BAR; PG8_WAIT_L(0); PG8_MMA(1, 0, At, B0); PG8_BAR; PG8_SCHED;
            PG8_STAGE(PG8_SB(0, 1), b2 + hstepB, voffB);
            PG8_WAIT_V(6); PG8_BAR; PG8_MMA(1, 1, At, B1); PG8_BAR;
            PG8_LDB(B0, 1, 0); PG8_SCHED; PG8_LDA(At, 1, 0); PG8_STAGE(PG8_SA(0, 1), a2 + hstepA, voffA);
            PG8_WAIT_L(8); PG8_BAR; PG8_WAIT_L(0); PG8_MMA(0, 0, At, B0); PG8_BAR; PG8_SCHED;
            PG8_LDB(B1, 1, 1); PG8_STAGE(PG8_SB(1, 0), b3, voffB);
            PG8_BAR; PG8_WAIT_L(0); PG8_MMA(0, 1, At, B1); PG8_BAR;
            PG8_LDA(At, 1, 1); PG8_STAGE(PG8_SA(1, 0), a3, voffA);
            PG8_BAR; PG8_WAIT_L(0); PG8_MMA(1, 0, At, B0); PG8_BAR; PG8_SCHED;
            PG8_STAGE(PG8_SB(1, 1), b3 + hstepB, voffB);
            PG8_WAIT_V(6); PG8_BAR; PG8_MMA(1, 1, At, B1); PG8_BAR;
            }
        }
        if constexpr (ALIGN_EPI) { if (wr == 0) PG8_BAR; }
        E(acc, cur, wr, wc, fr, fq);
        if (!has_next) break;
#pragma unroll
        for (int a = 0; a < 2; ++a)
#pragma unroll
            for (int b = 0; b < 2; ++b)
#pragma unroll
                for (int m = 0; m < 4; ++m)
#pragma unroll
                    for (int n = 0; n < 2; ++n) acc[a][b][m][n] = (f32x4){0.f, 0.f, 0.f, 0.f};
        cur = nxt; cA = nA; cB = nB; ++ui;
        if constexpr (ALIGN_EPI) { if (wr == 1) PG8_BAR; }
    }
    PG8_WAIT_V(0);
    if constexpr (!ALIGN_EPI) { if (wr == 0) PG8_BAR; }
    PG8_BAR;
#undef PG8_AOFF
#undef PG8_SA
#undef PG8_SB
#undef PG8_STAGE
#undef PG8_LDA
#undef PG8_LDB
#undef PG8_MMA
#undef PG8_WAIT_V
#undef PG8_WAIT_L
#undef PG8_BAR
#undef PG8_SCHED
}
}

#ifndef PG8_SP2
#define PG8_SP2 true
#endif
#ifndef PG8_ALIGN
#define PG8_ALIGN true
#endif

constexpr int NWAVES = 8;
constexpr int D = 2048, FF = 5632, BATCH = 4, SEQ = 2048, NMETA = 16, TP = SEQ + NMETA  , DEC_B = 128, DEC_T = 8;
constexpr int MPROMPT = BATCH * TP  , MSAMPLE = DEC_B * DEC_T  , MREAL = MPROMPT + MSAMPLE  , MP = 9472  , NMT = MP / 256;
constexpr int PHIST = 15, NSS = pg8::NSS;
constexpr float EPS = 1e-6f;
static_assert(MP % 256 == 0 && MP >= MREAL, "row padding");
constexpr size_t O_YP = 0, O_YS = O_YP + (size_t)BATCH * SEQ * D, O_NCP = O_YS + (size_t)MSAMPLE * D, O_NPP = O_NCP + (size_t)BATCH * 2 * D,
                 O_NCS = O_NPP + (size_t)BATCH * PHIST * D, O_NPS = O_NCS + (size_t)DEC_B * 2 * D, O_END = O_NPS + (size_t)DEC_B * PHIST * D;
constexpr size_t MiB = 1u << 20;
constexpr size_t WS_WIN = 0;
constexpr size_t WS_WOUT = 24 * MiB;
constexpr size_t WS_WPOOL = 32 * MiB;
constexpr size_t WS_WGU = 34 * MiB;
constexpr size_t WS_WDN = 122 * MiB;
constexpr size_t WS_XA = 166 * MiB, WS_XB = 203 * MiB;
constexpr size_t WS_BB = 240 * MiB, WS_UU = 277 * MiB;
constexpr size_t WS_H = 314 * MiB;
constexpr size_t WS_ACT = 388 * MiB;
constexpr size_t WS_SS = 490 * MiB;
constexpr size_t WS_CTL = 492 * MiB;
constexpr size_t WS_END = 493 * MiB;
static_assert((size_t)MP * D * 2 <= 37 * MiB && (size_t)MP * D * 4 <= 74 * MiB && (size_t)MP * FF * 2 <= 102 * MiB, "ws map");
constexpr int LDSCTL_OFF = 131072;
constexpr int LDS_BYTES = 147456;

#define GAS __attribute__((address_space(1)))
#define LAS __attribute__((address_space(3)))
typedef unsigned short bf16;
typedef unsigned v4u __attribute__((ext_vector_type(4)));
typedef unsigned v2u __attribute__((ext_vector_type(2)));
typedef float f32x4 __attribute__((ext_vector_type(4)));
#define LDS_WAIT() asm volatile("s_waitcnt lgkmcnt(0)" ::: "memory")
__device__ __forceinline__ unsigned f2bf(float f) { unsigned u = __builtin_bit_cast(unsigned, f); return (u + 0x7fffu + ((u >> 16) & 1u)) >> 16; }
__device__ __forceinline__ unsigned pk2(float lo, float hi) { return f2bf(lo) | (f2bf(hi) << 16); }
__device__ __forceinline__ float bf_lo(unsigned w) { return __builtin_bit_cast(float, w << 16); }
__device__ __forceinline__ float bf_hi(unsigned w) { return __builtin_bit_cast(float, w & 0xffff0000u); }
__device__ __forceinline__ float wave_sum(float v) {
#pragma unroll
    for (int o = 1; o < 64; o <<= 1) v += __shfl_xor(v, o);
    return v;
}


typedef GAS unsigned gu32;
#define XB_TMO      128
#define XB_XCNT(j)  (256  + 64 * (j))
#define XB_XSUB(j)  (1280 + 64 * (j))
#define XB_XGEN(j)  (2304 + 64 * (j))
#define XB_TOP      3328
#define XB_TOPGEN   3392
#define XCD_BAR_WORDS 3456
#define XB_SPIN_CAP (1u << 18)
__device__ __forceinline__ unsigned xb_ld(unsigned* p)              { return __hip_atomic_load(p, __ATOMIC_RELAXED, __HIP_MEMORY_SCOPE_AGENT); }
__device__ __forceinline__ unsigned xb_add(unsigned* p, unsigned v) { return __hip_atomic_fetch_add(p, v, __ATOMIC_RELAXED, __HIP_MEMORY_SCOPE_AGENT); }
__device__ __forceinline__ unsigned xb_xcc_id() { return (unsigned)__builtin_amdgcn_s_getreg((3 << 11) | 20) & 0xFu; }
#define XB_SPIN(cond, bar) do { unsigned _sp = 0; while (cond) { __builtin_amdgcn_s_sleep(1); \
    if ((++_sp & 255u) == 0u) { if (xb_ld(&(bar)[XB_TMO])) break; if (_sp > XB_SPIN_CAP) { atomicAdd(&(bar)[XB_TMO], 1u); break; } } } } while (0)
struct XcdBarrier { unsigned* bar; unsigned x; volatile LAS unsigned* st; };
__device__ __forceinline__ XcdBarrier xcd_barrier_post(unsigned* bar, volatile LAS unsigned* st) {
    XcdBarrier b; b.bar = bar; b.x = xb_xcc_id(); b.st = st;
    if (threadIdx.x == 0) (void)xb_add(&bar[XB_XCNT(b.x)], 1u);
    return b;
}
__device__ __forceinline__ void xcd_barrier_complete(unsigned* bar, unsigned x, unsigned& nloc, unsigned& nx) {
    const unsigned G = gridDim.x * gridDim.y * gridDim.z;
    unsigned sum, cnt, mine, sp = 0u;
    for (;;) {
        sum = 0u; cnt = 0u; mine = 0u;
#pragma unroll
        for (unsigned j = 0; j < 16; ++j) { const unsigned c = xb_ld(&bar[XB_XCNT(j)]); sum += c; cnt += (c > 0u) ? 1u : 0u; mine = (j == x) ? c : mine; }
        if (sum == G) break;
        __builtin_amdgcn_s_sleep(1);
        if ((++sp & 255u) == 0u) { if (xb_ld(&bar[XB_TMO])) break; if (sp > XB_SPIN_CAP) { atomicAdd(&bar[XB_TMO], 1u); break; } }
    }
    nloc = mine > 0u ? mine : 1u; nx = cnt > 0u ? cnt : 1u;
}
__device__ __forceinline__ void xcd_barrier(const XcdBarrier& b) {
    asm volatile("s_waitcnt vmcnt(0)" ::: "memory");
    __syncthreads();
    if (threadIdx.x == 0) {
        unsigned* bar = b.bar;
        __builtin_amdgcn_s_waitcnt(0);
        unsigned nloc = b.st[0], nx = b.st[1];
        if (nloc == 0u) { xcd_barrier_complete(bar, b.x, nloc, nx); b.st[0] = nloc; b.st[1] = nx; }
        const unsigned old = xb_add(&bar[XB_XSUB(b.x)], 1u);
        const unsigned gen = old / nloc;
        if (old + 1u == (gen + 1u) * nloc) {
            __builtin_amdgcn_fence(__ATOMIC_RELEASE, "agent");
            asm volatile("s_waitcnt vmcnt(0)" ::: "memory");
            const unsigned og = xb_add(&bar[XB_TOP], 1u);
            const unsigned tg = og / nx;
            if (og + 1u == (tg + 1u) * nx) xb_add(&bar[XB_TOPGEN], 1u);
            else XB_SPIN(xb_ld(&bar[XB_TOPGEN]) == tg, bar);
            __builtin_amdgcn_fence(__ATOMIC_ACQUIRE, "agent");
            xb_add(&bar[XB_XGEN(b.x)], 1u);
            asm volatile("s_waitcnt vmcnt(0)" ::: "memory");
        } else {
            XB_SPIN(xb_ld(&bar[XB_XGEN(b.x)]) == gen, bar);
            __builtin_amdgcn_fence(__ATOMIC_ACQUIRE, "agent");
            asm volatile("s_waitcnt vmcnt(0)" ::: "memory");
        }
    }
    __syncthreads();
}

struct Args {
    const float *x_prompt, *x_sample, *state_conv, *state_pool, *meta, *norm_mix, *norm_ffn, *norm_final, *w_in, *w_dw, *w_out, *pool_w, *pool_scale, *w_gu, *w_dn;
    float* out; unsigned char* ws;
};

__device__ __forceinline__ void p0_transpose_item(const float* W, int K, int N, bf16* WT, int drow0, LAS float* scr, int k0, int n0, int lane) {
#pragma unroll 8
    for (int i = 0; i < 32; ++i) { const int kk = 2 * i + (lane >> 5); scr[kk * 33 + (lane & 31)] = W[(size_t)(k0 + kk) * N + n0 + (lane & 31)]; }
    LDS_WAIT(); asm volatile("" ::: "memory");
    const int c = lane & 7;
#pragma unroll
    for (int j = 0; j < 4; ++j) { const int n = (lane >> 3) + 8 * j; const LAS float* s = scr + (8 * c) * 33 + n;
        v4u o; o.x = pk2(s[0 * 33], s[1 * 33]); o.y = pk2(s[2 * 33], s[3 * 33]); o.z = pk2(s[4 * 33], s[5 * 33]); o.w = pk2(s[6 * 33], s[7 * 33]);
        *(GAS v4u*)(WT + (size_t)(drow0 + n) * K + k0 + 8 * c) = o; }
    LDS_WAIT(); asm volatile("" ::: "memory");
}
__device__ __forceinline__ int pair_row(int n0, int NH) { const int s = n0 >= NH ? 1 : 0, j = n0 - s * NH; return (j >> 7) * 256 + s * 128 + (j & 127); }

__device__ __forceinline__ const float* x_row(const Args& a, int r) {
    if (r < MPROMPT) { const int b = r / TP, t = r - b * TP; return t < NMETA ? a.meta + (size_t)t * D : a.x_prompt + ((size_t)b * SEQ + (t - NMETA)) * D; }
    if (r < MREAL) return a.x_sample + (size_t)(r - MPROMPT) * D;
    return nullptr;
}

__global__ void __launch_bounds__(NWAVES * 64, 2) fwd_mega(Args a) {
    extern __shared__ __attribute__((aligned(16))) unsigned char lds_raw[];
    cg::grid_group grid = cg::this_grid();
    LAS unsigned char* lds = (LAS unsigned char*)lds_raw;
    const int tid = threadIdx.x, lane = tid & 63, wave = __builtin_amdgcn_readfirstlane(tid >> 6);
    const int G = gridDim.x; const int bx = blockIdx.x;
    const int vcu = (G % 8 == 0) ? (bx % 8) * (G / 8) + bx / 8 : bx;
    const int gw = vcu * NWAVES + wave, NGW = G * NWAVES;
    unsigned char* ws = a.ws;
    bf16* Win_t = (bf16*)(ws + WS_WIN); bf16* Wout_t = (bf16*)(ws + WS_WOUT); bf16* Wpool_t = (bf16*)(ws + WS_WPOOL);
    bf16* Wgu_t = (bf16*)(ws + WS_WGU); bf16* Wdn_t = (bf16*)(ws + WS_WDN);
    bf16* XA = (bf16*)(ws + WS_XA); bf16* XB = (bf16*)(ws + WS_XB); bf16* BB = (bf16*)(ws + WS_BB); bf16* UU = (bf16*)(ws + WS_UU);
    float* H = (float*)(ws + WS_H); bf16* ACT = (bf16*)(ws + WS_ACT); float* SS = (float*)(ws + WS_SS);
    unsigned* ctl = (unsigned*)(ws + WS_CTL);
    if (tid < 64) ((LAS unsigned*)(lds + LDSCTL_OFF))[tid] = 0u;
    if (bx == 0) for (int i = tid; i < XCD_BAR_WORDS; i += NWAVES * 64) __hip_atomic_store(ctl + i, 0u, __ATOMIC_RELAXED, __HIP_MEMORY_SCOPE_AGENT);
    __syncthreads();

    {
        LAS float* scr = (LAS float*)(lds + wave * 16384);
        constexpr int I_IN = (D / 64) * (3 * D / 32), I_OUT = (D / 64) * (D / 32), I_GU = (D / 64) * (2 * FF / 32), I_DN = (FF / 64) * (D / 32), I_PL = 4 * (512 / 64) * (512 / 32);
        constexpr int NITEMS = I_IN + I_OUT + 2 * I_GU + 2 * I_DN + I_PL;
        for (int it = gw; it < NITEMS; it += NGW) {
            int r = it;
            if (r < I_IN) { const int nblk = 3 * D / 32, k0 = 64 * (r / nblk), n0 = 32 * (r % nblk);
                const int drow = n0 < D ? n0 : D + pair_row(n0 - D, D);
                p0_transpose_item(a.w_in, D, 3 * D, Win_t, drow, scr, k0, n0, lane); continue; } r -= I_IN;
            if (r < I_OUT) { const int nblk = D / 32, k0 = 64 * (r / nblk), n0 = 32 * (r % nblk);
                p0_transpose_item(a.w_out, D, D, Wout_t, n0, scr, k0, n0, lane); continue; } r -= I_OUT;
            if (r < 2 * I_GU) { const int l = r / I_GU; r -= l * I_GU; const int nblk = 2 * FF / 32, k0 = 64 * (r / nblk), n0 = 32 * (r % nblk);
                p0_transpose_item(a.w_gu + (size_t)l * D * 2 * FF, D, 2 * FF, Wgu_t + (size_t)l * 2 * FF * D, pair_row(n0, FF), scr, k0, n0, lane); continue; } r -= 2 * I_GU;
            if (r < 2 * I_DN) { const int l = r / I_DN; r -= l * I_DN; const int nblk = D / 32, k0 = 64 * (r / nblk), n0 = 32 * (r % nblk);
                p0_transpose_item(a.w_dn + (size_t)l * FF * D, FF, D, Wdn_t + (size_t)l * D * FF, n0, scr, k0, n0, lane); continue; } r -= 2 * I_DN;
            { const int gq = r / 128; r -= gq * 128; const int nblk = 512 / 32, k0 = 64 * (r / nblk), n0 = 32 * (r % nblk);
                p0_transpose_item(a.pool_w + (size_t)gq * 512 * 512, 512, 512, Wpool_t + (size_t)gq * 512 * 512, n0, scr, k0, n0, lane); }
        }
        for (int r = gw; r < MP; r += NGW) {
            const float* xr = x_row(a, r);
            GAS f32x4* hrow = (GAS f32x4*)(H + (size_t)r * D) + lane; GAS v2u* orow = (GAS v2u*)(XA + (size_t)r * D) + lane;
            f32x4 v[8]; float s = 0.f;
#pragma unroll
            for (int j = 0; j < 8; ++j) { v[j] = xr ? ((const GAS f32x4*)xr)[lane + 64 * j] : (f32x4){0.f, 0.f, 0.f, 0.f}; s += (v[j][0] * v[j][0] + v[j][1] * v[j][1]) + (v[j][2] * v[j][2] + v[j][3] * v[j][3]); }
            const float rs = 1.0f / sqrtf(wave_sum(s) * (1.0f / D) + EPS);
#pragma unroll
            for (int j = 0; j < 8; ++j) { const f32x4 gm = ((const GAS f32x4*)a.norm_mix)[lane + 64 * j]; const f32x4 o = v[j] * rs * gm;
                hrow[64 * j] = v[j]; v2u w; w.x = pk2(o[0], o[1]); w.y = pk2(o[2], o[3]); orow[64 * j] = w; }
        }
    }
    grid.sync();
    (void)xcd_barrier_post(ctl, (volatile LAS unsigned*)(lds + LDSCTL_OFF) + 8);
#define GRID_BAR() do { XcdBarrier bar_; bar_.bar = (unsigned*)(a.ws + WS_CTL); bar_.x = xb_xcc_id(); bar_.st = (volatile LAS unsigned*)(lds + LDSCTL_OFF) + 8; xcd_barrier(bar_); } while (0)

    {
        pg8::Gemm g{XA, Win_t, D, D, 0}; pg8::StaticOrder S; S.init(NMT, 3 * D / 256, G, bx);
        pg8::EpiConvIn E{BB, UU};
        pg8::gemm_phase<pg8::EpiConvIn, pg8::StaticOrder, PG8_ALIGN, PG8_SP2>(lds, g, S, E);
    }
    GRID_BAR();

    for (int r = gw; r < MREAL; r += NGW) {
        const bool smp = r >= MPROMPT; const int rr = smp ? r - MPROMPT : r; const int b = smp ? rr / DEC_T : rr / TP; const int t = smp ? rr - b * DEC_T : rr - b * TP; const int T = smp ? DEC_T : TP;
        const float* hist = a.state_conv + (size_t)b * 2 * D;
#pragma unroll
        for (int j = 0; j < 4; ++j) {
            const int c = j * 512 + lane * 8;
            const v4u bb = *(const GAS v4u*)(BB + (size_t)r * D + c), u0 = *(const GAS v4u*)(UU + (size_t)r * D + c);
            float u0f[8], u1f[8], u2f[8], bf[8];
#pragma unroll
            for (int q = 0; q < 4; ++q) { u0f[2 * q] = bf_lo(u0[q]); u0f[2 * q + 1] = bf_hi(u0[q]); bf[2 * q] = bf_lo(bb[q]); bf[2 * q + 1] = bf_hi(bb[q]); }
            if (t >= 1) { const v4u w = *(const GAS v4u*)(UU + (size_t)(r - 1) * D + c);
#pragma unroll
                for (int q = 0; q < 4; ++q) { u1f[2 * q] = bf_lo(w[q]); u1f[2 * q + 1] = bf_hi(w[q]); } }
            else if (smp) { const f32x4 h0 = *(const GAS f32x4*)(hist + D + c), h1 = *(const GAS f32x4*)(hist + D + c + 4);
#pragma unroll
                for (int q = 0; q < 4; ++q) { u1f[q] = h0[q]; u1f[4 + q] = h1[q]; } }
            else {
#pragma unroll
                for (int q = 0; q < 8; ++q) u1f[q] = 0.f; }
            if (t >= 2) { const v4u w = *(const GAS v4u*)(UU + (size_t)(r - 2) * D + c);
#pragma unroll
                for (int q = 0; q < 4; ++q) { u2f[2 * q] = bf_lo(w[q]); u2f[2 * q + 1] = bf_hi(w[q]); } }
            else if (smp) { const f32x4 h0 = *(const GAS f32x4*)(hist + (size_t)t * D + c), h1 = *(const GAS f32x4*)(hist + (size_t)t * D + c + 4);
#pragma unroll
                for (int q = 0; q < 4; ++q) { u2f[q] = h0[q]; u2f[4 + q] = h1[q]; } }
            else {
#pragma unroll
                for (int q = 0; q < 8; ++q) u2f[q] = 0.f; }
            float o[8];
#pragma unroll
            for (int h = 0; h < 2; ++h) { const f32x4 w0 = *(const GAS f32x4*)(a.w_dw + c + 4 * h), w1 = *(const GAS f32x4*)(a.w_dw + D + c + 4 * h), w2 = *(const GAS f32x4*)(a.w_dw + 2 * D + c + 4 * h);
#pragma unroll
                for (int q = 0; q < 4; ++q) { const int e = 4 * h + q; o[e] = bf[e] * (w0[q] * u2f[e] + w1[q] * u1f[e] + w2[q] * u0f[e]); } }
            v4u w; w.x = pk2(o[0], o[1]); w.y = pk2(o[2], o[3]); w.z = pk2(o[4], o[5]); w.w = pk2(o[6], o[7]);
            *(GAS v4u*)(XB + (size_t)r * D + c) = w;
            if (t >= T - 2) { float* dst = a.out + (smp ? O_NCS : O_NCP) + ((size_t)b * 2 + (t - (T - 2))) * D + c;
                *(GAS f32x4*)dst = (f32x4){u0f[0], u0f[1], u0f[2], u0f[3]}; *(GAS f32x4*)(dst + 4) = (f32x4){u0f[4], u0f[5], u0f[6], u0f[7]}; }
        }
    }
    GRID_BAR();

    {
        pg8::Gemm g{XB, Wout_t, D, D, 0}; pg8::StaticOrder S; S.init(NMT, D / 256, G, bx);
        pg8::EpiRes<false, true> E{H, nullptr, a.norm_ffn, XA, SS};
        pg8::gemm_phase<pg8::EpiRes<false, true>, pg8::StaticOrder, PG8_ALIGN, PG8_SP2>(lds, g, S, E);
    }
    GRID_BAR();

    {
        pg8::Gemm g{XA, Wgu_t, D, D, 0}; pg8::StaticOrder S; S.init(NMT, 2 * FF / 256, G, bx);
        pg8::EpiGateUp E{ACT, SS};
        pg8::gemm_phase<pg8::EpiGateUp, pg8::StaticOrder, PG8_ALIGN, PG8_SP2>(lds, g, S, E);
    }
    GRID_BAR();

    {
        pg8::Gemm g{ACT, Wdn_t, FF, FF, 0}; pg8::StaticOrder S; S.init(NMT, D / 256, G, bx);
        pg8::EpiRes<false, false> E{H, nullptr, nullptr, nullptr, SS};
        pg8::gemm_phase<pg8::EpiRes<false, false>, pg8::StaticOrder, PG8_ALIGN, PG8_SP2>(lds, g, S, E);
    }
    GRID_BAR();

    {
        constexpr int CH = 8;
        constexpr int NCH_P = TP / CH  , ITEMS_P = BATCH * NCH_P * 8, ITEMS = ITEMS_P + DEC_B * 8;
        static_assert(TP % CH == 0 && DEC_T == CH, "pool chunking");
        for (int it = gw; it < ITEMS; it += NGW) {
            const int cs = it & 7, seq_chunk = it >> 3;
            const bool smp = it >= ITEMS_P;
            const int b = smp ? seq_chunk - BATCH * NCH_P : seq_chunk / NCH_P, t0 = smp ? 0 : (seq_chunk - b * NCH_P) * CH;
            const int base = smp ? MPROMPT + b * DEC_T : b * TP;
            const int c0 = cs * 256 + lane * 4, gi = cs >> 1, W = 2 << gi;
            const float* hist = a.state_pool + (size_t)b * PHIST * D;
            float rsv = 0.f;
            { const int t = t0 - 15 + lane; if (lane < CH + 15 && t >= 0) { const float* p = SS + (size_t)(base + t) * NSS; float s = 0.f;
#pragma unroll
                for (int q = 0; q < 8; ++q) { const f32x4 v = *(const GAS f32x4*)(p + 4 * q); s += (v[0] + v[1]) + (v[2] + v[3]); }
                rsv = 1.0f / sqrtf(s * (1.0f / D) + EPS); } }
            const f32x4 gm = *(const GAS f32x4*)(a.norm_mix + D + c0);
            f32x4 nv[CH + 15];
#pragma unroll
            for (int i = 0; i < CH + 15; ++i) { const int t = t0 - 15 + i; f32x4 v = (f32x4){0.f, 0.f, 0.f, 0.f};
                const float rsi = __shfl(rsv, i);
                if (i >= 16 - W) {
                    if (t >= 0) v = *(const GAS f32x4*)(H + (size_t)(base + t) * D + c0) * gm * rsi;
                    else if (smp) v = *(const GAS f32x4*)(hist + (size_t)(t + PHIST) * D + c0); }
                nv[i] = v; }
            f32x4 S4 = (f32x4){0.f, 0.f, 0.f, 0.f};
#pragma unroll
            for (int i = 0; i < 15; ++i) if (i >= 16 - W) S4 += nv[i];
#pragma unroll
            for (int k = 0; k < CH; ++k) { const int t = t0 + k; const f32x4 nt = nv[15 + k]; S4 += nt;
                const float cnt = smp ? (float)W : fminf((float)W, (float)(t + 1));
                const f32x4 p = S4 / cnt - nt;
                v2u w; w.x = pk2(p[0], p[1]); w.y = pk2(p[2], p[3]); *(GAS v2u*)(XB + (size_t)(base + t) * D + c0) = w;
                f32x4 old = nv[k];
                if (W == 8) old = nv[k + 8]; else if (W == 4) old = nv[k + 12]; else if (W == 2) old = nv[k + 14];
                S4 -= old;
                if (smp) *(GAS f32x4*)(a.out + O_NPS + ((size_t)b * PHIST + 7 + t) * D + c0) = nt;
                else if (t >= TP - PHIST) *(GAS f32x4*)(a.out + O_NPP + ((size_t)b * PHIST + (t - (TP - PHIST))) * D + c0) = nt; }
            if (smp) {
#pragma unroll
                for (int k = 0; k < 7; ++k) *(GAS f32x4*)(a.out + O_NPS + ((size_t)b * PHIST + k) * D + c0) = *(const GAS f32x4*)(hist + (size_t)(k + 8) * D + c0); }
        }
    }
    GRID_BAR();

    {
        pg8::Gemm g{XB, Wpool_t, D, 512, 2}; pg8::StaticOrder S; S.init(NMT, D / 256, G, bx);
        pg8::EpiRes<true, true> E{H, a.pool_scale, a.norm_ffn + D, XA, SS};
        pg8::gemm_phase<pg8::EpiRes<true, true>, pg8::StaticOrder, PG8_ALIGN, PG8_SP2>(lds, g, S, E);
    }
    GRID_BAR();

    {
        pg8::Gemm g{XA, Wgu_t + (size_t)2 * FF * D, D, D, 0}; pg8::StaticOrder S; S.init(NMT, 2 * FF / 256, G, bx);
        pg8::EpiGateUp E{ACT, SS};
        pg8::gemm_phase<pg8::EpiGateUp, pg8::StaticOrder, PG8_ALIGN, PG8_SP2>(lds, g, S, E);
    }
    GRID_BAR();

    {
        pg8::Gemm g{ACT, Wdn_t + (size_t)D * FF, FF, FF, 0}; pg8::StaticOrder S; S.init(NMT, D / 256, G, bx);
        pg8::EpiRes<false, false> E{H, nullptr, nullptr, nullptr, SS};
        pg8::gemm_phase<pg8::EpiRes<false, false>, pg8::StaticOrder, PG8_ALIGN, PG8_SP2>(lds, g, S, E);
    }
    GRID_BAR();

    for (int r = gw; r < MREAL; r += NGW) {
        float* dst;
        if (r < MPROMPT) { const int b = r / TP, t = r - b * TP; if (t < NMETA) continue; dst = a.out + O_YP + ((size_t)b * SEQ + (t - NMETA)) * D; }
        else dst = a.out + O_YS + (size_t)(r - MPROMPT) * D;
        float s = 0.f; { const float v = lane < NSS ? SS[(size_t)r * NSS + lane] : 0.f; s = wave_sum(v); }
        const float rs = 1.0f / sqrtf(s * (1.0f / D) + EPS);
        const GAS f32x4* hrow = (const GAS f32x4*)(H + (size_t)r * D) + lane;
        f32x4 v[8];
#pragma unroll
        for (int j = 0; j < 8; ++j) v[j] = hrow[64 * j];
#pragma unroll
        for (int j = 0; j < 8; ++j) { const f32x4 gm = ((const GAS f32x4*)a.norm_final)[lane + 64 * j]; ((GAS f32x4*)dst)[lane + 64 * j] = v[j] * rs * gm; }
    }
}

extern "C" void kernel_launch(void* const* d_in, const int* in_sizes, int n_in, void* d_out, int out_size, void* d_ws, size_t ws_size, hipStream_t stream) {
    static int grid = 0;
    if (grid == 0) {
        if (n_in != 15 || (size_t)out_size != O_END || ws_size < WS_END) { fprintf(stderr, "kernel_launch: unexpected shapes: n_in %d out %d ws %zu\n", n_in, out_size, ws_size); grid = -1; return; }
        int dev = 0, cus = 0, per_cu = 0;
        if (hipGetDevice(&dev) != hipSuccess || hipDeviceGetAttribute(&cus, hipDeviceAttributeMultiprocessorCount, dev) != hipSuccess) { grid = -1; return; }
        if (hipFuncSetAttribute((const void*)fwd_mega, hipFuncAttributeMaxDynamicSharedMemorySize, LDS_BYTES) != hipSuccess) { fprintf(stderr, "kernel_launch: hipFuncSetAttribute failed\n"); grid = -1; return; }
        if (hipOccupancyMaxActiveBlocksPerMultiprocessor(&per_cu, (const void*)fwd_mega, NWAVES * 64, LDS_BYTES) != hipSuccess || per_cu < 1) { fprintf(stderr, "kernel_launch: occupancy query says %d\n", per_cu); per_cu = 1; }
        (void)hipGetLastError();
        grid = cus * 1;
    }
    if (grid < 0) return;
    Args a{};
    a.x_prompt = (const float*)d_in[0]; a.x_sample = (const float*)d_in[1]; a.state_conv = (const float*)d_in[2]; a.state_pool = (const float*)d_in[3]; a.meta = (const float*)d_in[4];
    a.norm_mix = (const float*)d_in[5]; a.norm_ffn = (const float*)d_in[6]; a.norm_final = (const float*)d_in[7]; a.w_in = (const float*)d_in[8]; a.w_dw = (const float*)d_in[9];
    a.w_out = (const float*)d_in[10]; a.pool_w = (const float*)d_in[11]; a.pool_scale = (const float*)d_in[12]; a.w_gu = (const float*)d_in[13]; a.w_dn = (const float*)d_in[14];
    a.out = (float*)d_out; a.ws = (unsigned char*)d_ws;
    void* args[] = {&a};
    hipError_t e = hipLaunchCooperativeKernel((const void*)fwd_mega, dim3(grid), dim3(NWAVES * 64), args, LDS_BYTES, stream);
    if (e != hipSuccess) fprintf(stderr, "kernel_launch: cooperative launch failed: %s (grid %d)\n", hipGetErrorString(e), grid);
}
```
